# Optimizing an MI355X kernel written in HIP

```python
import jax
import jax.numpy as jnp
from jax import lax
import numpy as np

D_MODEL = 2048
BATCH = 16
SEQ = 2048
DEPTH = 4

HEAD_DIM = 128
SB_HEADS = 8
DSA_HEADS = 8
IDX_HEADS = 16
IDX_DIM = 64
TOPK_MAX = 256
D_FF = 5632
CONV_WIDTH = 3
Q_BLOCK = 128
ROPE_THETA = 10000.0
NORM_EPS = 1e-6
N_MOD = 6
SB_WIDTH = SB_HEADS * HEAD_DIM
DSA_WIDTH = DSA_HEADS * HEAD_DIM
IDX_Q_WIDTH = IDX_HEADS * IDX_DIM
IN_SPLIT_SIZES = (SB_WIDTH, SB_WIDTH, SB_WIDTH, DSA_WIDTH, DSA_WIDTH, DSA_WIDTH,
                  IDX_Q_WIDTH, IDX_DIM, IDX_HEADS, D_MODEL, D_MODEL)
IN_WIDTH = 3 * SB_WIDTH + 3 * DSA_WIDTH + IDX_Q_WIDTH + IDX_DIM + IDX_HEADS + 2 * D_MODEL

kernel_name = "hybrid_stickbreak_dsa_convffn_adaln"


def rmsnorm(x, g):
    xf = x.astype(jnp.float32)
    r = xf * lax.rsqrt(jnp.mean(xf * xf, axis=-1, keepdims=True) + NORM_EPS)
    return (r * g.astype(jnp.float32)).astype(x.dtype)


def rope(t, pos):
    d = t.shape[-1]
    inv_freq = 1.0 / (ROPE_THETA ** (jnp.arange(0, d, 2, dtype=jnp.float32) / d))
    ang = pos.astype(jnp.float32)[..., None] * inv_freq
    cos = jnp.cos(ang)[:, :, None, :]
    sin = jnp.sin(ang)[:, :, None, :]
    tf = t.astype(jnp.float32)
    t1, t2 = tf[..., : d // 2], tf[..., d // 2:]
    return jnp.concatenate([t1 * cos - t2 * sin, t2 * cos + t1 * sin], axis=-1).astype(t.dtype)


def stick_breaking_attention(q, k, v):
    B, S, H, dh = q.shape
    nb = S // Q_BLOCK
    scale = dh ** -0.5
    kpos = jnp.arange(S)
    qb = q.reshape(B, nb, Q_BLOCK, H, dh).transpose(1, 0, 2, 3, 4)

    def block(args):
        q_blk, start = args
        z = jnp.einsum('bqhd,bkhd->bhqk', q_blk, k,
                       preferred_element_type=jnp.float32) * scale
        qpos = start + jnp.arange(Q_BLOCK)
        past = (kpos[None, :] < qpos[:, None])[None, None]
        log1m = jnp.where(past, -jax.nn.softplus(z), 0.0)
        after = lax.cumsum(log1m, axis=3, reverse=True) - log1m
        w = jnp.where(past, jnp.exp(jax.nn.log_sigmoid(z) + after), 0.0)
        return jnp.einsum('bhqk,bkhd->bqhd', w.astype(v.dtype), v)

    starts = jnp.arange(nb, dtype=jnp.int32) * Q_BLOCK
    out = lax.map(block, (qb, starts))
    return out.transpose(1, 0, 2, 3, 4).reshape(B, S, H, dh)


def dsa_attention(q, k, v, qi, ki, wi):
    B, S, H, dh = q.shape
    nb = S // Q_BLOCK
    topk = min(TOPK_MAX, S // 4)
    kpos = jnp.arange(S)
    starts = jnp.arange(nb, dtype=jnp.int32) * Q_BLOCK

    def per_seq(args):
        q_s, k_s, v_s, qi_s, ki_s, wi_s = args
        q_blocks = q_s.reshape(nb, Q_BLOCK, H, dh)
        qi_blocks = qi_s.reshape(nb, Q_BLOCK, IDX_HEADS, IDX_DIM)
        wi_blocks = wi_s.reshape(nb, Q_BLOCK, IDX_HEADS)

        def block(bargs):
            q_b, qi_b, wi_b, start = bargs
            qpos = start + jnp.arange(Q_BLOCK)
            dots = jnp.einsum('qhi,ki->qhk', qi_b, ki_s,
                              preferred_element_type=jnp.float32) * (IDX_DIM ** -0.5)
            score = jnp.einsum('qh,qhk->qk', wi_b.astype(jnp.float32),
                               jax.nn.relu(dots)) * (IDX_HEADS ** -0.5)
            visible = kpos[None, :] <= qpos[:, None]
            score = jnp.where(visible, score, -jnp.inf)
            _, idx = lax.top_k(score, topk)
            k_sel = k_s[idx]
            v_sel = v_s[idx]
            logits = jnp.einsum('qhd,qkhd->qhk', q_b, k_sel,
                                preferred_element_type=jnp.float32) * (dh ** -0.5)
            valid = (idx <= qpos[:, None])[:, None, :]
            p = jax.nn.softmax(jnp.where(valid, logits, -jnp.inf), axis=-1)
            return jnp.einsum('qhk,qkhd->qhd', p.astype(v_s.dtype), v_sel)

        out = lax.map(block, (q_blocks, qi_blocks, wi_blocks, starts))
        return out.reshape(S, H, dh)

    return lax.map(per_seq, (q, k, v, qi, ki, wi))


def mixer(h, pos, w_in, w_a, w_b, w_o):
    B, S, _ = h.shape
    proj = h @ w_in
    offsets = [int(o) for o in np.cumsum(IN_SPLIT_SIZES)[:-1]]
    q_a, k_a, v_a, q_b, k_b, v_b, qi, ki, wi, g_a, g_b = jnp.split(proj, offsets, axis=-1)
    y_a = stick_breaking_attention(q_a.reshape(B, S, SB_HEADS, HEAD_DIM),
                                   k_a.reshape(B, S, SB_HEADS, HEAD_DIM),
                                   v_a.reshape(B, S, SB_HEADS, HEAD_DIM))
    y_a = y_a.reshape(B, S, SB_WIDTH) @ w_a
    y_b = dsa_attention(rope(q_b.reshape(B, S, DSA_HEADS, HEAD_DIM), pos),
                        rope(k_b.reshape(B, S, DSA_HEADS, HEAD_DIM), pos),
                        v_b.reshape(B, S, DSA_HEADS, HEAD_DIM),
                        rope(qi.reshape(B, S, IDX_HEADS, IDX_DIM), pos),
                        rope(ki[:, :, None, :], pos)[:, :, 0, :],
                        wi)
    y_b = y_b.reshape(B, S, DSA_WIDTH) @ w_b
    merged = jax.nn.sigmoid(g_a) * y_a + jax.nn.sigmoid(g_b) * y_b
    return merged @ w_o


def conv_ffn(h, w_up, conv_w, conv_b, w_down):
    u = h @ w_up
    S = u.shape[1]
    up = jnp.pad(u, ((0, 0), (CONV_WIDTH - 1, 0), (0, 0)))
    u = conv_b + sum(conv_w[i] * up[:, i:i + S] for i in range(CONV_WIDTH))
    a, b = jnp.split(u, 2, axis=-1)
    return (jax.nn.silu(a) * b) @ w_down


def setup_inputs(seed: int = 0) -> dict:
    key = jax.random.key(seed)
    ks = jax.random.split(key, 16)
    f32 = jnp.float32

    def nrm(k, shape, scale):
        return jax.random.normal(k, shape, f32) * scale

    x = nrm(ks[0], (BATCH, SEQ, D_MODEL), 1.0)
    c = nrm(ks[1], (BATCH, D_MODEL), 1.0)
    offset = jax.random.randint(ks[2], (BATCH, 1), 0, 4096, dtype=jnp.int32)
    positions = offset + jnp.arange(SEQ, dtype=jnp.int32)[None, :]
    w_in = nrm(ks[3], (DEPTH, D_MODEL, IN_WIDTH), D_MODEL ** -0.5)
    w_a = nrm(ks[4], (DEPTH, SB_WIDTH, D_MODEL), SB_WIDTH ** -0.5)
    w_b = nrm(ks[5], (DEPTH, DSA_WIDTH, D_MODEL), DSA_WIDTH ** -0.5)
    w_o = nrm(ks[6], (DEPTH, D_MODEL, D_MODEL), D_MODEL ** -0.5)
    w_ada = nrm(ks[7], (DEPTH, D_MODEL, N_MOD * D_MODEL), 0.1 * D_MODEL ** -0.5)
    b_ada = nrm(ks[8], (DEPTH, N_MOD * D_MODEL), 0.01)
    g_mix = 1.0 + nrm(ks[9], (DEPTH, D_MODEL), 0.02)
    g_ffn = 1.0 + nrm(ks[10], (DEPTH, D_MODEL), 0.02)
    w_up = nrm(ks[11], (DEPTH, D_MODEL, 2 * D_FF), D_MODEL ** -0.5)
    conv_w = nrm(ks[12], (DEPTH, CONV_WIDTH, 2 * D_FF), CONV_WIDTH ** -0.5)
    conv_b = nrm(ks[13], (DEPTH, 2 * D_FF), 0.01)
    w_down = nrm(ks[14], (DEPTH, D_FF, D_MODEL), D_FF ** -0.5)
    g_final = 1.0 + nrm(ks[15], (D_MODEL,), 0.02)
    return {"x": x, "c": c, "positions": positions, "w_in": w_in, "w_a": w_a, "w_b": w_b,
            "w_o": w_o, "w_ada": w_ada, "b_ada": b_ada, "g_mix": g_mix, "g_ffn": g_ffn,
            "w_up": w_up, "conv_w": conv_w, "conv_b": conv_b, "w_down": w_down,
            "g_final": g_final}


def reference(x, c, positions, w_in, w_a, w_b, w_o, w_ada, b_ada, g_mix, g_ffn,
              w_up, conv_w, conv_b, w_down, g_final):
    c_act = jax.nn.silu(c)
    for layer in range(DEPTH):
        mod = c_act @ w_ada[layer] + b_ada[layer]
        sh1, sc1, gt1, sh2, sc2, gt2 = jnp.split(mod[:, None, :], N_MOD, axis=-1)
        h = rmsnorm(x, g_mix[layer]) * (1 + sc1) + sh1
        x = x + (1 + gt1) * mixer(h, positions, w_in[layer], w_a[layer], w_b[layer], w_o[layer])
        h = rmsnorm(x, g_ffn[layer]) * (1 + sc2) + sh2
        x = x + (1 + gt2) * conv_ffn(h, w_up[layer], conv_w[layer], conv_b[layer], w_down[layer])
    return rmsnorm(x, g_final)
```

```cpp
#include <hip/hip_runtime.h>
#include <cstdio>
#include <cstdint>

#ifndef MK_ONE_LAUNCH
#define MK_ONE_LAUNCH 1
#endif

#define LAS __attribute__((address_space(3)))
#define GAS __attribute__((address_space(1)))
typedef unsigned short bf16_t;
typedef short bf16x8 __attribute__((ext_vector_type(8)));
typedef short s16x4 __attribute__((ext_vector_type(4)));
typedef float f32x4 __attribute__((ext_vector_type(4)));
typedef float f32x16 __attribute__((ext_vector_type(16)));
typedef unsigned u32x4 __attribute__((ext_vector_type(4)));
typedef unsigned u32x2 __attribute__((ext_vector_type(2)));

constexpr int DM = 2048, NBATCH = 16, SEQ = 2048, DEPTH = 4, MTOK = NBATCH * SEQ;
constexpr int DFF = 5632, NUP = 2 * DFF, NMOD = 6 * DM;
constexpr int IN_W = 11344;
constexpr int LDP = 11520;
constexpr int C_QSB = 0, C_KSB = 1024, C_VSB = 2048, C_QD = 3072, C_KD = 4096, C_VD = 5120, C_QI = 6144, C_SA = 7168, C_SB = 9216, C_KI = 11264, C_WI = 11328;
constexpr float NORM_EPS = 1e-6f;

constexpr size_t MiB = 1u << 20;
constexpr size_t WS_CTL = 0, CTL_BYTES = 1 * MiB;
constexpr size_t WS_MOD = 1 * MiB;
constexpr size_t WS_COS128 = 4 * MiB, WS_SIN128 = 12 * MiB;
constexpr size_t WS_COS64 = 20 * MiB, WS_SIN64 = 24 * MiB;
constexpr size_t WS_MASK = 28 * MiB;
constexpr size_t WS_WIN = 36 * MiB;
constexpr size_t WS_WAB = 81 * MiB;
constexpr size_t WS_WO = 89 * MiB;
constexpr size_t WS_WUP = 97 * MiB;
constexpr size_t WS_WDN = 141 * MiB;
constexpr size_t WS_HB = 163 * MiB;
constexpr size_t WS_Y = 291 * MiB;
constexpr size_t WS_PROJ = 419 * MiB;
constexpr size_t WS_ACT = 1139 * MiB;
constexpr size_t WS_H0 = 1491 * MiB;
constexpr size_t WS_H1 = 1503 * MiB;
constexpr size_t WS_END = 1515 * MiB;

namespace pg8 {
constexpr int BM = 256, BK = 64, HALF = 128, HTB = HALF * BK * 2, STAGE_BYTES = 8 * HTB, NXCD = 8, WGM = 4;
__host__ __device__ __forceinline__ int lds_byte(int r, int c) { const int st = (r >> 4) * 2 + (c >> 5), rr = r & 15, cc = c & 31, ob = rr * 64 + cc * 2; return st * 1024 + (ob ^ (((ob >> 9) & 1) << 5)); }
__host__ __device__ __forceinline__ void stage_rc(int b, int& R, int& C) { const int st = b / 1024, sb = b % 1024, swz = sb ^ (((sb >> 9) & 1) << 5); R = (st >> 1) * 16 + swz / 64; C = (st & 1) * 32 + (swz % 64) / 2; }
__host__ __device__ __forceinline__ int perm32(int rho) { const int n = rho >> 4, i = rho & 15; return 8 * (i >> 2) + 4 * n + (i & 3); }
struct Unit { int pm, pn; };
struct Gemm { const GAS bf16_t* A; const GAS bf16_t* Bt; int M, N, K; };
struct StaticOrder {
    int nM, nN, nwg, G, c;
    __host__ __device__ void init(int M, int N, int G_, int c_) { nM = M / BM; nN = N / BM; nwg = nM * nN; G = G_; c = c_; }
    __host__ __device__ bool next(int i, Unit& u) const {
        const long L = (long)i * G + c; if (L >= nwg) return false;
        int wgid = (int)L; { const int q = nwg / NXCD, r = nwg % NXCD, xcd = wgid % NXCD, off = wgid / NXCD; wgid = (xcd < r ? xcd * (q + 1) : r * (q + 1) + (xcd - r) * q) + off; }
        const int nig = WGM * nN, gid = wgid / nig, fm = gid * WGM, gsz = (nM - fm) < WGM ? (nM - fm) : WGM;
        u.pm = fm + ((wgid % nig) % gsz); u.pn = (wgid % nig) / gsz; return true;
    }
    __device__ __forceinline__ void a_ready(const Unit&) const {}
    __device__ __forceinline__ void done(const Unit&) const {}
};

template <class Epi, class Sched, bool ALIGN_EPI = false, bool SP2 = false>
__device__ __forceinline__ void gemm_phase(LAS unsigned char* lds, const Gemm g, const Sched& S, const Epi& E) {
    int tid = threadIdx.x; asm volatile("" : "+v"(tid));
    const int wid = __builtin_amdgcn_readfirstlane(tid >> 6), lane = tid & 63, wr = wid >> 2, wc = wid & 3, fr = lane & 15, fq = lane >> 4;
    const int K = g.K, nt = K / BK;
    unsigned voffA[2], voffB[2];
#pragma unroll
    for (int i = 0; i < 2; ++i) { int R, C; stage_rc(tid * 16 + i * 8192, R, C); const int Rb = Epi::PERM ? ((R & ~31) + perm32(R & 31)) : R;
        voffA[i] = (unsigned)(R * K + C) * 2u; voffB[i] = (unsigned)(Rb * K + C) * 2u; }
    const size_t kstep = (size_t)(BK * 2);
    const size_t hstep = (size_t)HALF * K * 2;
    const size_t tstep = 2 * hstep;
    const unsigned ldsw = (unsigned)wid * 1024u;
    const int aoff = lds_byte(wr * 64 + fr, fq * 8), boff = lds_byte(wc * 32 + fr, fq * 8);
#define PG8_SA(b, h) (((b) * 2 + (h)) * HTB)
#define PG8_SB(b, h) ((4 + (b) * 2 + (h)) * HTB)
#define PG8_STAGE(bufoff, gbase, voff) do { _Pragma("unroll") for (int _i = 0; _i < 2; ++_i) \
        __builtin_amdgcn_global_load_lds((const GAS unsigned*)((const GAS char*)(gbase) + (voff)[_i]), (LAS unsigned*)(lds + (bufoff) + ldsw + _i * 8192), 16, 0, 0); } while (0)
#define PG8_LDA(dst, b, h) do { _Pragma("unroll") for (int m = 0; m < 4; ++m) _Pragma("unroll") for (int k = 0; k < 2; ++k) dst[m][k] = *(const LAS bf16x8*)(lds + PG8_SA(b, h) + aoff + m * 2048 + k * 1024); } while (0)
#define PG8_LDB(dst, b, h) do { _Pragma("unroll") for (int n = 0; n < 2; ++n) _Pragma("unroll") for (int k = 0; k < 2; ++k) dst[n][k] = *(const LAS bf16x8*)(lds + PG8_SB(b, h) + boff + n * 2048 + k * 1024); } while (0)
#define PG8_MMA(ai, bj, At, Bt) do { __builtin_amdgcn_s_setprio(1); _Pragma("unroll") for (int m = 0; m < 4; ++m) _Pragma("unroll") for (int n = 0; n < 2; ++n) _Pragma("unroll") for (int k = 0; k < 2; ++k) \
        acc[ai][bj][m][n] = __builtin_amdgcn_mfma_f32_16x16x32_bf16(Bt[n][k], At[m][k], acc[ai][bj][m][n], 0, 0, 0); __builtin_amdgcn_s_setprio(0); } while (0)
#define PG8_WAIT_V(n) asm volatile("s_waitcnt vmcnt(" #n ")" ::: "memory")
#define PG8_WAIT_L(n) asm volatile("s_waitcnt lgkmcnt(" #n ")" ::: "memory")
#define PG8_BAR __builtin_amdgcn_s_barrier()
#define PG8_SCHED __builtin_amdgcn_sched_barrier(0)
    Unit cur, nxt; int ui = 0;
    if (!S.next(0, cur)) return;
    f32x4 acc[2][2][4][2];
#pragma unroll
    for (int a = 0; a < 2; ++a)
#pragma unroll
        for (int b = 0; b < 2; ++b)
#pragma unroll
            for (int m = 0; m < 4; ++m)
#pragma unroll
                for (int n = 0; n < 2; ++n) acc[a][b][m][n] = (f32x4){0.f, 0.f, 0.f, 0.f};
    bf16x8 At[4][2], B0[2][2], B1[2][2];
    const GAS char* cA = (const GAS char*)g.A + (size_t)cur.pm * tstep; const GAS char* cB = (const GAS char*)g.Bt + (size_t)cur.pn * tstep;
    S.a_ready(cur);
    if constexpr (SP2) {
        PG8_STAGE(PG8_SB(0, 0), cB, voffB); PG8_STAGE(PG8_SB(0, 1), cB + hstep, voffB); PG8_STAGE(PG8_SA(0, 0), cA, voffA); PG8_STAGE(PG8_SA(0, 1), cA + hstep, voffA);
        if (wr == 1) PG8_BAR;
        PG8_WAIT_V(2); PG8_BAR;
        PG8_STAGE(PG8_SB(1, 0), cB + kstep, voffB); PG8_STAGE(PG8_SA(1, 0), cA + kstep, voffA); PG8_STAGE(PG8_SB(1, 1), cB + hstep + kstep, voffB);
        PG8_WAIT_V(6); PG8_BAR;
    } else {
        PG8_STAGE(PG8_SB(0, 0), cB, voffB); PG8_STAGE(PG8_SA(0, 0), cA, voffA); PG8_STAGE(PG8_SB(0, 1), cB + hstep, voffB); PG8_STAGE(PG8_SA(0, 1), cA + hstep, voffA);
        if (wr == 1) PG8_BAR;
        PG8_WAIT_V(4); PG8_BAR;
        PG8_STAGE(PG8_SB(1, 0), cB + kstep, voffB); PG8_STAGE(PG8_SA(1, 0), cA + kstep, voffA); PG8_STAGE(PG8_SB(1, 1), cB + hstep + kstep, voffB);
        PG8_WAIT_V(6); PG8_BAR;
    }
    for (;;) {
        const bool has_next = S.next(ui + 1, nxt);
        const GAS char* nA = has_next ? (const GAS char*)g.A + (size_t)nxt.pm * tstep : cA; const GAS char* nB = has_next ? (const GAS char*)g.Bt + (size_t)nxt.pn * tstep : cB;
        for (int t = 0; t < nt; t += 2) {
            const bool last = (t == nt - 2);
            const GAS char* a1 = cA + (size_t)(t + 1) * kstep;
            const GAS char* a2 = last ? nA : cA + (size_t)(t + 2) * kstep; const GAS char* b2 = last ? nB : cB + (size_t)(t + 2) * kstep;
            const GAS char* a3 = a2 + kstep; const GAS char* b3 = b2 + kstep;
            if (last && has_next) S.a_ready(nxt);
            if constexpr (Epi::HAS_MID) { if (t == (nt >> 1)) E.mid(acc, cur, wr, wc, fr, fq); }
            if constexpr (SP2) {
            PG8_LDB(B0, 0, 0); PG8_LDB(B1, 0, 1); PG8_SCHED; PG8_LDA(At, 0, 0); PG8_STAGE(PG8_SA(1, 1), a1 + hstep, voffA);
            PG8_WAIT_V(8); PG8_WAIT_L(0); PG8_BAR; PG8_MMA(0, 0, At, B0); PG8_MMA(0, 1, At, B1); PG8_BAR; PG8_SCHED;
            PG8_LDA(At, 0, 1); PG8_STAGE(PG8_SB(0, 0), b2, voffB); PG8_STAGE(PG8_SB(0, 1), b2 + hstep, voffB); PG8_STAGE(PG8_SA(0, 0), a2, voffA);
            PG8_WAIT_V(8); PG8_WAIT_L(0); PG8_BAR; PG8_MMA(1, 0, At, B0); PG8_MMA(1, 1, At, B1); PG8_BAR; PG8_SCHED;
            PG8_LDB(B0, 1, 0); PG8_LDB(B1, 1, 1); PG8_SCHED; PG8_LDA(At, 1, 0); PG8_STAGE(PG8_SA(0, 1), a2 + hstep, voffA);
            PG8_WAIT_V(8); PG8_WAIT_L(0); PG8_BAR; PG8_MMA(0, 0, At, B0); PG8_MMA(0, 1, At, B1); PG8_BAR; PG8_SCHED;
            PG8_LDA(At, 1, 1); PG8_STAGE(PG8_SB(1, 0), b3, voffB); PG8_STAGE(PG8_SB(1, 1), b3 + hstep, voffB); PG8_STAGE(PG8_SA(1, 0), a3, voffA);
            PG8_WAIT_V(8); PG8_WAIT_L(0); PG8_BAR; PG8_MMA(1, 0, At, B0); PG8_MMA(1, 1, At, B1); PG8_BAR; PG8_SCHED;
            } else {
            PG8_LDB(B0, 0, 0); PG8_SCHED; PG8_LDA(At, 0, 0); PG8_STAGE(PG8_SA(1, 1), a1 + hstep, voffA);
            PG8_WAIT_L(8); PG8_BAR; PG8_WAIT_L(0); PG8_MMA(0, 0, At, B0); PG8_BAR; PG8_SCHED;
            PG8_LDB(B1, 0, 1); PG8_STAGE(PG8_SB(0, 0), b2, voffB);
            PG8_BAR; PG8_WAIT_L(0); PG8_MMA(0, 1, At, B1); PG8_BAR;
            PG8_LDA(At, 0, 1); PG8_STAGE(PG8_SA(0, 0), a2, voffA);
            PG8_BAR; PG8_WAIT_L(0); PG8_MMA(1, 0, At, B0); PG8_BAR; PG8_SCHED;
            PG8_STAGE(PG8_SB(0, 1), b2 + hstep, voffB);
            PG8_WAIT_V(6); PG8_BAR; PG8_MMA(1, 1, At, B1); PG8_BAR;
            PG8_LDB(B0, 1, 0); PG8_SCHED; PG8_LDA(At, 1, 0); PG8_STAGE(PG8_SA(0, 1), a2 + hstep, voffA);
            PG8_WAIT_L(8); PG8_BAR; PG8_WAIT_L(0); PG8_MMA(0, 0, At, B0); PG8_BAR; PG8_SCHED;
            PG8_LDB(B1, 1, 1); PG8_STAGE(PG8_SB(1, 0), b3, voffB);
            PG8_BAR; PG8_WAIT_L(0); PG8_MMA(0, 1, At, B1); PG8_BAR;
            PG8_LDA(At, 1, 1); PG8_STAGE(PG8_SA(1, 0), a3, voffA);
            PG8_BAR; PG8_WAIT_L(0); PG8_MMA(1, 0, At, B0); PG8_BAR; PG8_SCHED;
            PG8_STAGE(PG8_SB(1, 1), b3 + hstep, voffB);
            PG8_WAIT_V(6); PG8_BAR; PG8_MMA(1, 1, At, B1); PG8_BAR;
            }
        }
        if constexpr (ALIGN_EPI) { if (wr == 0) PG8_BAR; }
        E(acc, cur, wr, wc, fr, fq); S.done(cur);
        if (!has_next) break;
#pragma unroll
        for (int a = 0; a < 2; ++a)
#pragma unroll
            for (int b = 0; b < 2; ++b)
#pragma unroll
                for (int m = 0; m < 4; ++m)
#pragma unroll
                    for (int n = 0; n < 2; ++n) acc[a][b][m][n] = (f32x4){0.f, 0.f, 0.f, 0.f};
        cur = nxt; cA = nA; cB = nB; ++ui;
        if constexpr (ALIGN_EPI) { if (wr == 1) PG8_BAR; }
    }
    PG8_WAIT_V(0);
    if constexpr (!ALIGN_EPI) { if (wr == 0) PG8_BAR; }
    PG8_BAR;
#undef PG8_SA
#undef PG8_SB
#undef PG8_STAGE
#undef PG8_LDA
#undef PG8_LDB
#undef PG8_MMA
#undef PG8_WAIT_V
#undef PG8_WAIT_L
#undef PG8_BAR
#undef PG8_SCHED
}
}

#define LDS_WAIT() asm volatile("s_waitcnt lgkmcnt(0)" ::: "memory")
#define VM_WAIT() asm volatile("s_waitcnt vmcnt(0)" ::: "memory")
#define SBAR() __builtin_amdgcn_sched_barrier(0)
typedef float f32x2 __attribute__((ext_vector_type(2)));
typedef __bf16 bf16x2_t __attribute__((ext_vector_type(2)));
__device__ __forceinline__ unsigned cvtpk(float lo, float hi) { const f32x2 v = {lo, hi}; return __builtin_bit_cast(unsigned, __builtin_convertvector(v, bf16x2_t)); }
__device__ __forceinline__ float bf_lo(unsigned w) { return __uint_as_float(w << 16); }
__device__ __forceinline__ float bf_hi(unsigned w) { return __uint_as_float(w & 0xffff0000u); }
__device__ __forceinline__ u32x4 pack8f(f32x4 a, f32x4 b) { u32x4 w = {cvtpk(a[0], a[1]), cvtpk(a[2], a[3]), cvtpk(b[0], b[1]), cvtpk(b[2], b[3])}; return w; }
__device__ __forceinline__ float wave_sum(float v) {
#pragma unroll
    for (int o = 1; o < 64; o <<= 1) v += __shfl_xor(v, o);
    return v;
}
__device__ __forceinline__ float fast_sigmoid(float v) { return __builtin_amdgcn_rcpf(1.f + __builtin_amdgcn_exp2f(-1.4426950408889634f * v)); }

#define XB_TMO      128
#define XB_XCNT(j)  (256  + 64 * (j))
#define XB_XSUB(j)  (1280 + 64 * (j))
#define XB_XGEN(j)  (2304 + 64 * (j))
#define XB_TOP      3328
#define XB_TOPGEN   3392
#define XCD_BAR_WORDS 3456
#define XB_SPIN_CAP (1u << 22)
__device__ __forceinline__ unsigned xb_ld(unsigned* p)              { return __hip_atomic_load(p, __ATOMIC_RELAXED, __HIP_MEMORY_SCOPE_AGENT); }
__device__ __forceinline__ unsigned xb_add(unsigned* p, unsigned v) { return __hip_atomic_fetch_add(p, v, __ATOMIC_RELAXED, __HIP_MEMORY_SCOPE_AGENT); }
__device__ __forceinline__ unsigned xb_xcc_id() { return (unsigned)__builtin_amdgcn_s_getreg((3 << 11) | 20) & 0xFu; }
#define XB_SPIN(cond, bar) do { unsigned _sp = 0; while (cond) { __builtin_amdgcn_s_sleep(1); \
    if ((++_sp & 255u) == 0u) { if (xb_ld(&(bar)[XB_TMO])) break; if (_sp > XB_SPIN_CAP) { atomicAdd(&(bar)[XB_TMO], 1u); break; } } } } while (0)
struct XcdBarrier { unsigned* bar; unsigned x; volatile LAS unsigned* st; };
__device__ __forceinline__ XcdBarrier xcd_barrier_post(unsigned* bar, volatile LAS unsigned* st) {
    XcdBarrier b; b.bar = bar; b.x = xb_xcc_id(); b.st = st;
    if (threadIdx.x == 0) (void)xb_add(&bar[XB_XCNT(b.x)], 1u);
    return b;
}
__device__ __forceinline__ void xcd_barrier_complete(unsigned* bar, unsigned x, unsigned& nloc, unsigned& nx) {
    const unsigned G = gridDim.x * gridDim.y * gridDim.z;
    unsigned sum, cnt, mine, sp = 0u;
    for (;;) {
        sum = 0u; cnt = 0u; mine = 0u;
#pragma unroll
        for (unsigned j = 0; j < 16; ++j) { const unsigned c = xb_ld(&bar[XB_XCNT(j)]); sum += c; cnt += (c > 0u) ? 1u : 0u; mine = (j == x) ? c : mine; }
        if (sum == G) break;
        __builtin_amdgcn_s_sleep(1);
        if ((++sp & 255u) == 0u) { if (xb_ld(&bar[XB_TMO])) break; if (sp > XB_SPIN_CAP) { atomicAdd(&bar[XB_TMO], 1u); break; } }
    }
    nloc = mine > 0u ? mine : 1u; nx = cnt > 0u ? cnt : 1u;
}
__device__ __forceinline__ void xcd_barrier(const XcdBarrier& b) {
    asm volatile("s_waitcnt vmcnt(0)" ::: "memory");
    __syncthreads();
    if (threadIdx.x == 0) {
        unsigned* bar = b.bar;
        __builtin_amdgcn_s_waitcnt(0);
        unsigned nloc = b.st[0], nx = b.st[1];
        if (nloc == 0u) { xcd_barrier_complete(bar, b.x, nloc, nx); b.st[0] = nloc; b.st[1] = nx; }
        const unsigned old = xb_add(&bar[XB_XSUB(b.x)], 1u);
        const unsigned gen = old / nloc;
        if (old + 1u == (gen + 1u) * nloc) {
            __builtin_amdgcn_fence(__ATOMIC_RELEASE, "agent");
            asm volatile("s_waitcnt vmcnt(0)" ::: "memory");
            const unsigned og = xb_add(&bar[XB_TOP], 1u);
            const unsigned tg = og / nx;
            if (og + 1u == (tg + 1u) * nx) xb_add(&bar[XB_TOPGEN], 1u);
            else XB_SPIN(xb_ld(&bar[XB_TOPGEN]) == tg, bar);
            __builtin_amdgcn_fence(__ATOMIC_ACQUIRE, "agent");
            xb_add(&bar[XB_XGEN(b.x)], 1u);
            asm volatile("s_waitcnt vmcnt(0)" ::: "memory");
        } else {
            XB_SPIN(xb_ld(&bar[XB_XGEN(b.x)]) == gen, bar);
            __builtin_amdgcn_fence(__ATOMIC_ACQUIRE, "agent");
            asm volatile("s_waitcnt vmcnt(0)" ::: "memory");
        }
    }
    __syncthreads();
}

using pg8::Unit;
struct EpiInProj {
    static constexpr bool PERM = true, HAS_MID = false;
    GAS bf16_t* O; const GAS float* cos128; const GAS float* sin128; const GAS float* cos64; const GAS float* sin64; GAS bf16_t* kix;
    template <int KIND>
    __device__ __forceinline__ void tile(const f32x4 (&acc)[2][2][4][2], const Unit& u, int wr, int wc, int fr, int fq) const {
        asm volatile("" : "+v"(fr), "+v"(fq));
        const int row0 = u.pm * 256 + wr * 64 + fr, col0 = u.pn * 256 + wc * 32 + 8 * fq;
#pragma unroll
        for (int ai = 0; ai < 2; ++ai) {
            f32x4 csv[4], snv[4];
#pragma unroll
            for (int m = 0; m < 4; ++m) { const int row = row0 + ai * 128 + m * 16;
                csv[m] = (f32x4){1.f, 1.f, 1.f, 1.f}; snv[m] = (f32x4){0.f, 0.f, 0.f, 0.f};
                if (KIND == 1) { csv[m] = *(const GAS f32x4*)(cos128 + (size_t)row * 64 + 16 * wc + 4 * fq); snv[m] = *(const GAS f32x4*)(sin128 + (size_t)row * 64 + 16 * wc + 4 * fq); }
                if (KIND == 2 || KIND == 4) { csv[m] = *(const GAS f32x4*)(cos64 + (size_t)row * 32 + 16 * (wc & 1) + 4 * fq); snv[m] = *(const GAS f32x4*)(sin64 + (size_t)row * 32 + 16 * (wc & 1) + 4 * fq); } }
#pragma unroll
            for (int m = 0; m < 4; ++m) {
                const int row = row0 + ai * 128 + m * 16;
                GAS bf16_t* rowp = O + (size_t)row * LDP + col0;
                const f32x4 cs = csv[m], sn = snv[m];
#pragma unroll
                for (int bj = 0; bj < 2; ++bj) {
                    f32x4 v0 = acc[ai][bj][m][0], v1 = acc[ai][bj][m][1];
                    bool rope = (KIND == 1 || KIND == 2);
                    if (KIND == 4) rope = (bj == 0 && wc < 2);
                    if (rope) { const f32x4 a = v0 * cs - v1 * sn, b = v1 * cs + v0 * sn; v0 = a; v1 = b; }
                    if (KIND == 3) {
#pragma unroll
                        for (int j = 0; j < 4; ++j) { v0[j] = fast_sigmoid(v0[j]); v1[j] = fast_sigmoid(v1[j]); }
                    }
                    if (KIND == 3) __builtin_nontemporal_store(pack8f(v0, v1), (GAS u32x4*)(rowp + bj * 128));
                    else *(GAS u32x4*)(rowp + bj * 128) = pack8f(v0, v1);
                    if (KIND == 4 && bj == 0 && wc < 2) {
                        const int g_ = 4 * wc + fq; *(GAS u32x4*)(kix + ((size_t)(row >> 5) * 4 + (g_ >> 1)) * 512 + (size_t)((row & 31) + 32 * (g_ & 1)) * 8) = pack8f(v0, v1); }
                }
            }
            asm volatile("" ::: "memory");
        }
    }
    __device__ __forceinline__ void operator()(const f32x4 (&acc)[2][2][4][2], const Unit& u, int wr, int wc, int fr, int fq) const {
        const int pn = u.pn;
        if (pn < 12 || (pn >= 20 && pn < 24)) tile<0>(acc, u, wr, wc, fr, fq);
        else if (pn < 20) tile<1>(acc, u, wr, wc, fr, fq);
        else if (pn < 28) tile<2>(acc, u, wr, wc, fr, fq);
        else if (pn < 44) tile<3>(acc, u, wr, wc, fr, fq);
        else tile<4>(acc, u, wr, wc, fr, fq);
    }
    __device__ __forceinline__ void mid(f32x4 (&)[2][2][4][2], const Unit&, int, int, int, int) const {}
};
struct EpiGate {
    static constexpr bool PERM = true, HAS_MID = true;
    const GAS bf16_t* P; GAS bf16_t* O;
    __device__ __forceinline__ void mid(f32x4 (&acc)[2][2][4][2], const Unit& u, int wr, int wc, int fr, int fq) const {
        asm volatile("" : "+v"(fr), "+v"(fq));
        const int row0 = u.pm * 256 + wr * 64 + fr, col0 = u.pn * 256 + wc * 32 + 8 * fq;
#pragma unroll
        for (int ai = 0; ai < 2; ++ai)
#pragma unroll
            for (int mp = 0; mp < 2; ++mp) {
                u32x4 sa[2][2], sb[2][2];
#pragma unroll
                for (int m2 = 0; m2 < 2; ++m2) { const GAS bf16_t* rowp = P + (size_t)(row0 + ai * 128 + (2 * mp + m2) * 16) * LDP + col0;
#pragma unroll
                    for (int bj = 0; bj < 2; ++bj) { sa[m2][bj] = __builtin_nontemporal_load((const GAS u32x4*)(rowp + C_SA + bj * 128)); sb[m2][bj] = __builtin_nontemporal_load((const GAS u32x4*)(rowp + C_SB + bj * 128)); } }
#pragma unroll
                for (int m2 = 0; m2 < 2; ++m2)
#pragma unroll
                    for (int bj = 0; bj < 2; ++bj)
#pragma unroll
                        for (int q = 0; q < 4; ++q) {
                            const float r0 = bf_lo(sa[m2][bj][q]) * __builtin_amdgcn_rcpf(fmaxf(bf_lo(sb[m2][bj][q]), 1e-30f));
                            const float r1 = bf_hi(sa[m2][bj][q]) * __builtin_amdgcn_rcpf(fmaxf(bf_hi(sb[m2][bj][q]), 1e-30f));
                            acc[ai][bj][2 * mp + m2][q >> 1][(q & 1) * 2 + 0] *= r0; acc[ai][bj][2 * mp + m2][q >> 1][(q & 1) * 2 + 1] *= r1;
                        }
                asm volatile("" ::: "memory");
            }
    }
    __device__ __forceinline__ void operator()(const f32x4 (&acc)[2][2][4][2], const Unit& u, int wr, int wc, int fr, int fq) const {
        asm volatile("" : "+v"(fr), "+v"(fq));
        const int row0 = u.pm * 256 + wr * 64 + fr, col0 = u.pn * 256 + wc * 32 + 8 * fq;
#pragma unroll
        for (int ai = 0; ai < 2; ++ai)
#pragma unroll
            for (int mp = 0; mp < 2; ++mp) {
                u32x4 sb[2][2];
#pragma unroll
                for (int m2 = 0; m2 < 2; ++m2)
#pragma unroll
                    for (int bj = 0; bj < 2; ++bj) sb[m2][bj] = __builtin_nontemporal_load((const GAS u32x4*)(P + (size_t)(row0 + ai * 128 + (2 * mp + m2) * 16) * LDP + col0 + C_SB + bj * 128));
#pragma unroll
                for (int m2 = 0; m2 < 2; ++m2)
#pragma unroll
                    for (int bj = 0; bj < 2; ++bj) {
                        const int row = row0 + ai * 128 + (2 * mp + m2) * 16; const u32x4 w = sb[m2][bj];
                        f32x4 v0 = acc[ai][bj][2 * mp + m2][0], v1 = acc[ai][bj][2 * mp + m2][1];
                        v0[0] *= fmaxf(bf_lo(w[0]), 1e-30f); v0[1] *= fmaxf(bf_hi(w[0]), 1e-30f); v0[2] *= fmaxf(bf_lo(w[1]), 1e-30f); v0[3] *= fmaxf(bf_hi(w[1]), 1e-30f);
                        v1[0] *= fmaxf(bf_lo(w[2]), 1e-30f); v1[1] *= fmaxf(bf_hi(w[2]), 1e-30f); v1[2] *= fmaxf(bf_lo(w[3]), 1e-30f); v1[3] *= fmaxf(bf_hi(w[3]), 1e-30f);
                        *(GAS u32x4*)(O + (size_t)row * DM + col0 + bj * 128) = pack8f(v0, v1);
                    }
                asm volatile("" ::: "memory");
            }
    }
};
__device__ __forceinline__ float dpp_ror8f(float v) { return __builtin_bit_cast(float, __builtin_amdgcn_update_dpp(0, __builtin_bit_cast(int, v), 0x128, 0xf, 0xf, false)); }
__device__ __forceinline__ f32x4 dpp_ror8v(f32x4 v) { f32x4 r; r.x = dpp_ror8f(v.x); r.y = dpp_ror8f(v.y); r.z = dpp_ror8f(v.z); r.w = dpp_ror8f(v.w); return r; }
struct EpiResid {
    static constexpr bool PERM = false, HAS_MID = false;
    GAS float* X; const GAS float* Xin; const GAS float* gate;
    __device__ __forceinline__ void operator()(const f32x4 (&acc)[2][2][4][2], const Unit& u, int wr, int wc, int fr, int fq) const {
        asm volatile("" : "+v"(fr), "+v"(fq));
        const bool lo = fr < 8;
        const int col0 = u.pn * 256 + wc * 32 + 4 * fq;
        const int rowA = u.pm * 256 + wr * 64 + (fr & 7), colA = col0 + (lo ? 0 : 16);
        const GAS float* gp = gate + (size_t)(u.pm >> 3) * NMOD + col0;
        f32x4 gv[2][2];
#pragma unroll
        for (int bj = 0; bj < 2; ++bj)
#pragma unroll
            for (int n = 0; n < 2; ++n) gv[bj][n] = *(const GAS f32x4*)(gp + bj * 128 + n * 16);
        asm volatile("" : "+v"(gv[0][0]), "+v"(gv[0][1]), "+v"(gv[1][0]), "+v"(gv[1][1]));
#pragma unroll
        for (int bj = 0; bj < 2; ++bj)
#pragma unroll
            for (int n = 0; n < 2; ++n) gv[bj][n] = gv[bj][n] + 1.0f;
#pragma unroll
        for (int ai = 0; ai < 2; ++ai) {
            f32x4 xv[4][2][2];
#pragma unroll
            for (int m = 0; m < 4; ++m) { const GAS float* rowp = Xin + (size_t)(rowA + ai * 128 + m * 16) * DM + colA;
#pragma unroll
                for (int bj = 0; bj < 2; ++bj)
#pragma unroll
                    for (int h = 0; h < 2; ++h) xv[m][bj][h] = *(const GAS f32x4*)(rowp + (size_t)h * 8 * DM + bj * 128); }
#pragma unroll
            for (int m = 0; m < 4; ++m) { GAS float* rowp = X + (size_t)(rowA + ai * 128 + m * 16) * DM + colA;
#pragma unroll
                for (int bj = 0; bj < 2; ++bj) {
                    const f32x4 d0 = gv[bj][0] * acc[ai][bj][m][0], d1 = gv[bj][1] * acc[ai][bj][m][1];
                    const f32x4 rcv = dpp_ror8v(lo ? d1 : d0);
                    *(GAS f32x4*)(rowp + bj * 128) = xv[m][bj][0] + (lo ? d0 : rcv);
                    *(GAS f32x4*)(rowp + (size_t)8 * DM + bj * 128) = xv[m][bj][1] + (lo ? rcv : d1);
                }
            }
            asm volatile("" ::: "memory");
        }
    }
    __device__ __forceinline__ void mid(f32x4 (&)[2][2][4][2], const Unit&, int, int, int, int) const {}
};
#define DPP_SHR1 0x111
#define DPP_SHR2 0x112
#define DPP_ROR1 0x121
#define DPP_ROR2 0x122
__device__ __forceinline__ float dpp_prev1(float cur, float prv) {
    return __builtin_bit_cast(float, __builtin_amdgcn_update_dpp(__builtin_amdgcn_update_dpp(0, __builtin_bit_cast(int, prv), DPP_ROR1, 0xf, 0xf, false), __builtin_bit_cast(int, cur), DPP_SHR1, 0xf, 0xf, false)); }
__device__ __forceinline__ float dpp_prev2(float cur, float prv) {
    return __builtin_bit_cast(float, __builtin_amdgcn_update_dpp(__builtin_amdgcn_update_dpp(0, __builtin_bit_cast(int, prv), DPP_ROR2, 0xf, 0xf, false), __builtin_bit_cast(int, cur), DPP_SHR2, 0xf, 0xf, false)); }
struct EpiConv {
    static constexpr bool PERM = true, HAS_MID = false;
    GAS bf16_t* ACT; GAS float* H0; GAS float* H1; const GAS float* cw; const GAS float* cb; LAS unsigned char* ex;
    __device__ __forceinline__ void operator()(const f32x4 (&acc)[2][2][4][2], const Unit& u, int wr, int wc, int fr, int fq) const {
        asm volatile("" : "+v"(fr), "+v"(fq));
        const int row0 = u.pm * 256 + wr * 64 + fr, chl = wc * 32 + 8 * fq, ch0 = u.pn * 128 + chl;
        f32x4 w0[2][2], w1[2][2], w2[2][2], bs[2][2];
#pragma unroll
        for (int bj = 0; bj < 2; ++bj)
#pragma unroll
            for (int n = 0; n < 2; ++n) { const int c = bj * DFF + ch0 + 4 * n;
                w0[bj][n] = *(const GAS f32x4*)(cw + c); w1[bj][n] = *(const GAS f32x4*)(cw + NUP + c); w2[bj][n] = *(const GAS f32x4*)(cw + 2 * NUP + c); bs[bj][n] = *(const GAS f32x4*)(cb + c); }
        const int slot_l = ((wc * 4 + fq) * 2) * 16;
#pragma unroll
        for (int ai = 0; ai < 2; ++ai) { const int Q = 2 * ai + wr;
            if (Q < 3 && fr >= 14) {
#pragma unroll
                for (int bj = 0; bj < 2; ++bj)
#pragma unroll
                    for (int n = 0; n < 2; ++n) *(LAS f32x4*)(ex + Q * 2048 + (fr - 14) * 1024 + bj * 512 + slot_l + n * 16) = acc[ai][bj][3][n]; } }
        if (wr == 0 && fr < 2) {
#pragma unroll
            for (int bj = 0; bj < 2; ++bj)
#pragma unroll
                for (int n = 0; n < 2; ++n) *(GAS f32x4*)(H0 + ((size_t)u.pm * 2 + fr) * NUP + u.pn * 256 + bj * 128 + chl + 4 * n) = acc[0][bj][0][n]; }
        if (wr == 1 && fr >= 14) {
#pragma unroll
            for (int bj = 0; bj < 2; ++bj)
#pragma unroll
                for (int n = 0; n < 2; ++n) *(GAS f32x4*)(H1 + ((size_t)u.pm * 2 + (fr - 14)) * NUP + u.pn * 256 + bj * 128 + chl + 4 * n) = acc[1][bj][3][n]; }
        asm volatile("s_waitcnt lgkmcnt(0)" ::: "memory");
        __builtin_amdgcn_s_barrier();
        asm volatile("" ::: "memory");
#pragma unroll
        for (int ai = 0; ai < 2; ++ai) {
            const int Q = 2 * ai + wr;
            f32x4 pv[2][2];
#pragma unroll
            for (int bj = 0; bj < 2; ++bj)
#pragma unroll
                for (int n = 0; n < 2; ++n) { pv[bj][n] = (f32x4){0.f, 0.f, 0.f, 0.f};
                    if (Q > 0 && fr >= 14) pv[bj][n] = *(const LAS f32x4*)(ex + (Q - 1) * 2048 + (fr - 14) * 1024 + bj * 512 + slot_l + n * 16); }
#pragma unroll
            for (int m = 0; m < 4; ++m) {
                f32x4 cv[2][2];
#pragma unroll
                for (int bj = 0; bj < 2; ++bj)
#pragma unroll
                    for (int n = 0; n < 2; ++n) {
                        const f32x4 cur = acc[ai][bj][m][n]; const f32x4 prv = (m == 0) ? pv[bj][n] : acc[ai][bj][m > 0 ? m - 1 : 0][n];
                        f32x4 p1, p2;
                        p1.x = dpp_prev1(cur.x, prv.x); p1.y = dpp_prev1(cur.y, prv.y); p1.z = dpp_prev1(cur.z, prv.z); p1.w = dpp_prev1(cur.w, prv.w);
                        p2.x = dpp_prev2(cur.x, prv.x); p2.y = dpp_prev2(cur.y, prv.y); p2.z = dpp_prev2(cur.z, prv.z); p2.w = dpp_prev2(cur.w, prv.w);
                        cv[bj][n] = bs[bj][n] + w0[bj][n] * p2 + w1[bj][n] * p1 + w2[bj][n] * cur;
                    }
                f32x4 o0, o1;
#pragma unroll
                for (int j = 0; j < 4; ++j) { o0[j] = cv[0][0][j] * fast_sigmoid(cv[0][0][j]) * cv[1][0][j]; o1[j] = cv[0][1][j] * fast_sigmoid(cv[0][1][j]) * cv[1][1][j]; }
                const int row = row0 + ai * 128 + m * 16;
                if (!(Q == 0 && m == 0 && fr < 2)) *(GAS u32x4*)(ACT + (size_t)row * DFF + ch0) = pack8f(o0, o1);
            }
        }
    }
    __device__ __forceinline__ void mid(f32x4 (&)[2][2][4][2], const Unit&, int, int, int, int) const {}
};
constexpr int KVBLK = 64, SHM_K = KVBLK * 128 * 2, SHM_V = SHM_K;
constexpr float ATT_SCALE = 0.08838834764831845f;
#define KSWZ(row, colB) ((row) * 256 + ((colB) ^ (((row) & 7) << 4)))
__device__ __forceinline__ int v_st(int k, int c) { const int kk = (k & ~0xC) | ((k & 4) << 1) | ((k & 8) >> 1); return ((kk >> 3) * 4 + (c >> 5)) * 512 + ((kk & 7) * 32 + (c & 31)) * 2; }
__device__ __forceinline__ int v_rd_base(int lane) { return ((lane & 3) << 3) | (((lane >> 2) & 3) << 6) | (((lane >> 4) & 1) << 5) | (((lane >> 5) & 1) << 8); }
constexpr int v_rd_off(int d0, int ks, int half) { return d0 * 512 + ks * 4096 + half * 2048; }
__device__ __forceinline__ int crow(int r, int hi) { return (r & 3) + 8 * (r >> 2) + 4 * hi; }
template <int KB>
__device__ __forceinline__ void qkt(f32x16& p0, f32x16& p1, const LAS char* K_lds, int r32, int hi, const bf16x8* qr) {
    p0 = f32x16{}; p1 = f32x16{};
    int ka[4];
#pragma unroll
    for (int dd = 0; dd < 4; ++dd) ka[dd] = (int)(uintptr_t)(K_lds + KB * SHM_K + KSWZ(r32, (dd * 16 + hi * 8) * 2));
    bf16x8 fa0, fa1, fb0, fb1, fc0, fc1;
#define KRD1(dst, d0, off) asm volatile("ds_read_b128 %0, %1 offset:%2" : "=&v"(dst) : "v"(ka[(d0) & 3]), "i"(((d0) >> 2) * 128 + (off)) : "memory")
#define KRD(S, d0) do { KRD1(S##0, d0, 0); KRD1(S##1, d0, 32 * 256); } while (0)
#define KMM(S, d0, n) do { asm volatile("s_waitcnt lgkmcnt(" #n ")" ::: "memory"); SBAR(); \
        p0 = __builtin_amdgcn_mfma_f32_32x32x16_bf16(S##0, qr[d0], p0, 0, 0, 0); p1 = __builtin_amdgcn_mfma_f32_32x32x16_bf16(S##1, qr[d0], p1, 0, 0, 0); SBAR(); } while (0)
    KRD(fa, 0); KRD(fb, 1);
    KRD(fc, 2); KMM(fa, 0, 4);
    KRD(fa, 3); KMM(fb, 1, 4);
    KRD(fb, 4); KMM(fc, 2, 4);
    KRD(fc, 5); KMM(fa, 3, 4);
    KRD(fa, 6); KMM(fb, 4, 4);
    KRD(fb, 7); KMM(fc, 5, 4);
    KMM(fa, 6, 2);
    KMM(fb, 7, 0);
#undef KMM
#undef KRD
#undef KRD1
}
template <int VB>
__device__ __forceinline__ void pv_tile(f32x16* o, int vb0, bf16x8 pa0, bf16x8 pa1, bf16x8 pa2, bf16x8 pa3) {
#define TRRD(dst, off) asm volatile("ds_read_b64_tr_b16 %0, %1 offset:%2" : "=&v"(dst) : "v"(vb0), "i"(off) : "memory")
#define PV_RD(S, d0) do { constexpr int b_ = VB * SHM_V + v_rd_off(d0, 0, 0); \
        TRRD(S##l0, b_); TRRD(S##h0, b_ + 2048); TRRD(S##l1, b_ + 4096); TRRD(S##h1, b_ + 6144); TRRD(S##l2, b_ + 8192); TRRD(S##h2, b_ + 10240); TRRD(S##l3, b_ + 12288); TRRD(S##h3, b_ + 14336); } while (0)
#define PV_MM(S, d0, n) do { asm volatile("s_waitcnt lgkmcnt(" #n ")" ::: "memory"); SBAR(); \
        o[d0] = __builtin_amdgcn_mfma_f32_32x32x16_bf16(pa0, (bf16x8){S##l0[0], S##l0[1], S##l0[2], S##l0[3], S##h0[0], S##h0[1], S##h0[2], S##h0[3]}, o[d0], 0, 0, 0);   \
        o[d0] = __builtin_amdgcn_mfma_f32_32x32x16_bf16(pa1, (bf16x8){S##l1[0], S##l1[1], S##l1[2], S##l1[3], S##h1[0], S##h1[1], S##h1[2], S##h1[3]}, o[d0], 0, 0, 0);   \
        o[d0] = __builtin_amdgcn_mfma_f32_32x32x16_bf16(pa2, (bf16x8){S##l2[0], S##l2[1], S##l2[2], S##l2[3], S##h2[0], S##h2[1], S##h2[2], S##h2[3]}, o[d0], 0, 0, 0);   \
        o[d0] = __builtin_amdgcn_mfma_f32_32x32x16_bf16(pa3, (bf16x8){S##l3[0], S##l3[1], S##l3[2], S##l3[3], S##h3[0], S##h3[1], S##h3[2], S##h3[3]}, o[d0], 0, 0, 0); SBAR(); } while (0)
    s16x4 Al0, Al1, Al2, Al3, Ah0, Ah1, Ah2, Ah3, Bl0, Bl1, Bl2, Bl3, Bh0, Bh1, Bh2, Bh3;
    PV_RD(A, 0); PV_RD(B, 1);
    PV_MM(A, 0, 8);
    PV_RD(A, 2); PV_MM(B, 1, 8);
    PV_RD(B, 3); PV_MM(A, 2, 8);
    PV_MM(B, 3, 0);
#undef PV_MM
#undef PV_RD
#undef TRRD
}
__device__ __forceinline__ void pack_p(const f32x16& p0, const f32x16& p1, bf16x8& pa0, bf16x8& pa1, bf16x8& pa2, bf16x8& pa3) {
#define PK4(P, B_, OUT) do { unsigned a0 = cvtpk(P[B_+0], P[B_+1]), a1 = cvtpk(P[B_+2], P[B_+3]);                          \
        unsigned b0 = cvtpk(P[B_+4], P[B_+5]), b1 = cvtpk(P[B_+6], P[B_+7]);                                             \
        auto r0 = __builtin_amdgcn_permlane32_swap(a0, b0, false, false); auto r1 = __builtin_amdgcn_permlane32_swap(a1, b1, false, false); \
        u32x4 w = {r0[0], r1[0], r0[1], r1[1]}; OUT = *reinterpret_cast<bf16x8*>(&w); } while (0)
    PK4(p0, 0, pa0); PK4(p0, 8, pa1); PK4(p1, 0, pa2); PK4(p1, 8, pa3);
#undef PK4
}
__device__ __forceinline__ float other_half(float x, int hi) {
    auto rr = __builtin_amdgcn_permlane32_swap(__float_as_uint(x), __float_as_uint(x), false, false);
    return __uint_as_float(hi ? rr[0] : rr[1]);
}

__device__ __forceinline__ void store_o(const f32x16* o, GAS bf16_t* Ow, int r32, int hi, const float* rscale  ) {
#pragma unroll
    for (int r = 0; r < 16; ++r) { const int orow = crow(r, hi);
#pragma unroll
        for (int d0 = 0; d0 < 4; ++d0) { const float v = rscale ? o[d0][r] * rscale[r] : o[d0][r];
            const float vn = __shfl_xor(v, 1);
            if ((r32 & 1) == 0) *(GAS unsigned*)(Ow + (size_t)orow * DM + d0 * 32 + r32) = cvtpk(v, vn); } }
}

constexpr int ATT_LDS_WS = 2 * SHM_V + 2 * SHM_K;
__device__ __forceinline__ void sb_attn_unit(LAS char* lds, const GAS bf16_t* proj, GAS bf16_t* Y, int b, int h, int qb) {
    int tid = threadIdx.x; asm volatile("" : "+v"(tid));
    const int wid = __builtin_amdgcn_readfirstlane(tid >> 6), lane = tid & 63, r32 = lane & 31, hi = lane >> 5;
    LAS char* V_lds = lds; LAS char* K_lds = lds + 2 * SHM_V;
    volatile LAS unsigned* flags = (volatile LAS unsigned*)(lds + ATT_LDS_WS + 8 * 256);
    const int q0 = qb * 256, qlo = q0 + wid * 32, trow = qlo + r32;
    const GAS bf16_t* Qp = proj + (size_t)(b * SEQ + q0) * LDP + C_QSB + h * 128;
    const GAS bf16_t* Kp = proj + (size_t)(b * SEQ) * LDP + C_KSB + h * 128;
    const GAS bf16_t* Vp = proj + (size_t)(b * SEQ) * LDP + C_VSB + h * 128;
    bf16x8 qr[8];
#pragma unroll
    for (int d0 = 0; d0 < 8; ++d0) qr[d0] = *(const GAS bf16x8*)(Qp + (size_t)(wid * 32 + r32) * LDP + d0 * 16 + hi * 8);
    const int NT = qb * 4 + 4;
    const int sr = tid >> 4, sc = (tid & 15) * 8, vst0 = v_st(sr, sc), vst1 = v_st(32 + sr, sc), kws = KSWZ(sr, sc * 2);
    const int vb0 = (int)(uintptr_t)V_lds + v_rd_base(lane);
    bf16x8 st_k0, st_k1, st_v0, st_v1;
#define SB_LOAD(k0) do { st_v0 = *(const GAS bf16x8*)(Vp + (size_t)((k0) + sr) * LDP + sc); st_v1 = *(const GAS bf16x8*)(Vp + (size_t)((k0) + 32 + sr) * LDP + sc); \
                         st_k0 = *(const GAS bf16x8*)(Kp + (size_t)((k0) + sr) * LDP + sc); st_k1 = *(const GAS bf16x8*)(Kp + (size_t)((k0) + 32 + sr) * LDP + sc); } while (0)
#define SB_WRITE(bf) do { *(LAS bf16x8*)(V_lds + (bf) * SHM_V + vst0) = st_v0; *(LAS bf16x8*)(V_lds + (bf) * SHM_V + vst1) = st_v1; \
                          *(LAS bf16x8*)(K_lds + (bf) * SHM_K + kws) = st_k0; *(LAS bf16x8*)(K_lds + (bf) * SHM_K + kws + 32 * 256) = st_k1; } while (0)
    f32x16 o[4] = {};
    float C = 0.f;
    SB_LOAD((NT - 1) * 64); VM_WAIT(); SB_WRITE(0);
    if (NT > 1) SB_LOAD((NT - 2) * 64);
    __syncthreads();
    int it = 0;
    constexpr float C2S = ATT_SCALE * 1.4426950408889634f;
    for (;;) {
#define SB_BODY(BUF) { \
        const int kb = (NT - 1 - it) * 64; const bool has_next = (it + 1 < NT); \
        if (has_next) { VM_WAIT(); SB_WRITE((BUF) ^ 1); } \
        if (it + 2 < NT) SB_LOAD(kb - 128); \
        if (kb < qlo + 31) { \
            f32x16 p0, p1; qkt<BUF>(p0, p1, K_lds, r32, hi, qr); \
            const int dq = trow - kb - 4 * hi; \
            float Lv[32]; \
            const bool diag = (kb + 63 >= qlo);            \
            _Pragma("unroll") for (int r = 0; r < 16; ++r) { const int c = (r & 3) + 8 * (r >> 2); \
                { const float z = p0[r] * C2S; const float L = fmaxf(z, 0.f) + __builtin_amdgcn_logf(1.f + __builtin_amdgcn_exp2f(-fabsf(z))); const bool v = c < dq; Lv[r] = v ? L : 0.f; p0[r] = z - L; } \
                { const float z = p1[r] * C2S; const float L = fmaxf(z, 0.f) + __builtin_amdgcn_logf(1.f + __builtin_amdgcn_exp2f(-fabsf(z))); const bool v = (c + 32) < dq; Lv[16 + r] = v ? L : 0.f; p1[r] = z - L; } } \
              \
            float T[8], Tb[8], S[8]; \
            _Pragma("unroll") for (int q = 0; q < 8; ++q) T[q] = (Lv[4 * q] + Lv[4 * q + 1]) + (Lv[4 * q + 2] + Lv[4 * q + 3]); \
            _Pragma("unroll") for (int q = 0; q < 8; ++q) Tb[q] = other_half(T[q], hi); \
            float run = C; \
            _Pragma("unroll") for (int q = 7; q >= 0; --q) { S[q] = run + (hi ? 0.f : Tb[q]); run += T[q] + Tb[q]; } \
            C = run; \
            _Pragma("unroll") for (int q = 0; q < 8; ++q) { \
                const float e3 = S[q], e2 = e3 + Lv[4 * q + 3], e1 = e2 + Lv[4 * q + 2], e0 = e1 + Lv[4 * q + 1]; \
                const int cb = (q & 3) * 8 + (q >> 2) * 32; \
                if (q < 4) { p0[4 * q + 0] = __builtin_amdgcn_exp2f(p0[4 * q + 0] - e0); p0[4 * q + 1] = __builtin_amdgcn_exp2f(p0[4 * q + 1] - e1); \
                             p0[4 * q + 2] = __builtin_amdgcn_exp2f(p0[4 * q + 2] - e2); p0[4 * q + 3] = __builtin_amdgcn_exp2f(p0[4 * q + 3] - e3); } \
                else { const int qq = q - 4; \
                             p1[4 * qq + 0] = __builtin_amdgcn_exp2f(p1[4 * qq + 0] - e0); p1[4 * qq + 1] = __builtin_amdgcn_exp2f(p1[4 * qq + 1] - e1); \
                             p1[4 * qq + 2] = __builtin_amdgcn_exp2f(p1[4 * qq + 2] - e2); p1[4 * qq + 3] = __builtin_amdgcn_exp2f(p1[4 * qq + 3] - e3); } } \
            if (diag) { _Pragma("unroll") for (int r = 0; r < 16; ++r) { const int c = (r & 3) + 8 * (r >> 2); p0[r] = (c < dq) ? p0[r] : 0.f; p1[r] = ((c + 32) < dq) ? p1[r] : 0.f; } } \
            bf16x8 pa0, pa1, pa2, pa3; pack_p(p0, p1, pa0, pa1, pa2, pa3); \
            pv_tile<BUF>(o, vb0, pa0, pa1, pa2, pa3); \
        } \
        { const bool done = __all(C > 160.f); if (lane == 0) flags[(it & 1) * 8 + wid] = done ? 1u : 0u; } \
        __syncthreads(); \
        ++it; if (it >= NT) break; \
        { unsigned all = 1u; _Pragma("unroll") for (int w = 0; w < 8; ++w) all &= flags[((it - 1) & 1) * 8 + w]; if (all) break; } }
        SB_BODY(0)
        SB_BODY(1)
#undef SB_BODY
    }
    store_o(o, Y + (size_t)(b * SEQ + qlo) * DM + h * 128, r32, hi, nullptr);
    __syncthreads();
#undef SB_LOAD
#undef SB_WRITE
}

constexpr float DSA_THR = 8.f;
__device__ __forceinline__ float dsa_msk(float p, int m, int c) { const int s = __builtin_amdgcn_sbfe(m, c, 1); return __builtin_bit_cast(float, (__builtin_bit_cast(int, p) & s) | (~s & (int)0xFF800000)); }
__device__ __forceinline__ void dsa_attn_unit(LAS char* lds, const GAS bf16_t* proj, const GAS unsigned long long* maskw, GAS bf16_t* Y, int b, int h, int qb) {
    int tid = threadIdx.x; asm volatile("" : "+v"(tid));
    const int wid = __builtin_amdgcn_readfirstlane(tid >> 6), lane = tid & 63, r32 = lane & 31, hi = lane >> 5;
    LAS char* V_lds = lds; LAS char* K_lds = lds + 2 * SHM_V;
    LAS float* ws = (LAS float*)(lds + ATT_LDS_WS) + wid * 64; LAS float* li_l = ws; LAS float* al_l = ws + 32;
    const int q0 = qb * 256, qlo = q0 + wid * 32, trow = qlo + r32;
    const GAS bf16_t* Qp = proj + (size_t)(b * SEQ + q0) * LDP + C_QD + h * 128;
    const GAS bf16_t* Kp = proj + (size_t)(b * SEQ) * LDP + C_KD + h * 128;
    const GAS bf16_t* Vp = proj + (size_t)(b * SEQ) * LDP + C_VD + h * 128;
    const GAS unsigned long long* mrow = maskw + (size_t)(b * SEQ + trow) * 32;
    bf16x8 qr[8];
#pragma unroll
    for (int d0 = 0; d0 < 8; ++d0) qr[d0] = *(const GAS bf16x8*)(Qp + (size_t)(wid * 32 + r32) * LDP + d0 * 16 + hi * 8);
    const int NT = qb * 4 + 4;
    const int sr = tid >> 4, sc = (tid & 15) * 8, vst0 = v_st(sr, sc), vst1 = v_st(32 + sr, sc), kws = KSWZ(sr, sc * 2);
    const int vb0 = (int)(uintptr_t)V_lds + v_rd_base(lane);
    bf16x8 st_k0, st_k1, st_v0, st_v1;
#define DS_LOAD(k0) do { st_v0 = *(const GAS bf16x8*)(Vp + (size_t)((k0) + sr) * LDP + sc); st_v1 = *(const GAS bf16x8*)(Vp + (size_t)((k0) + 32 + sr) * LDP + sc); \
                         st_k0 = *(const GAS bf16x8*)(Kp + (size_t)((k0) + sr) * LDP + sc); st_k1 = *(const GAS bf16x8*)(Kp + (size_t)((k0) + 32 + sr) * LDP + sc); } while (0)
#define DS_WRITE(bf) do { *(LAS bf16x8*)(V_lds + (bf) * SHM_V + vst0) = st_v0; *(LAS bf16x8*)(V_lds + (bf) * SHM_V + vst1) = st_v1; \
                          *(LAS bf16x8*)(K_lds + (bf) * SHM_K + kws) = st_k0; *(LAS bf16x8*)(K_lds + (bf) * SHM_K + kws + 32 * 256) = st_k1; } while (0)
    f32x16 o[4] = {};
    float m_reg = -1e30f, l_reg = 0.f;
    unsigned long long mw = mrow[0], mw_next = 0ull;
    DS_LOAD(0); VM_WAIT(); DS_WRITE(0);
    if (NT > 1) DS_LOAD(64);
    __syncthreads();
    constexpr float C2 = 1.4426950408889634f * ATT_SCALE;
    int it = 0;
    for (;;) {
#define DS_BODY(BUF) { \
        const int kb = it * 64; const bool has_next = (it + 1 < NT); \
        if (has_next) { VM_WAIT(); DS_WRITE((BUF) ^ 1); mw_next = mrow[it + 1]; }        \
        if (it + 2 < NT) DS_LOAD(kb + 128); \
        if (kb <= qlo + 31) { \
            f32x16 p0, p1; qkt<BUF>(p0, p1, K_lds, r32, hi, qr); \
            const int m0 = (int)((unsigned)mw >> (4 * hi)), m1 = (int)((unsigned)(mw >> 32) >> (4 * hi)); \
              \
            p0[0] = dsa_msk(p0[0], m0, 0); p1[0] = dsa_msk(p1[0], m1, 0); \
            p0[1] = dsa_msk(p0[1], m0, 1); p1[1] = dsa_msk(p1[1], m1, 1); \
            p0[2] = dsa_msk(p0[2], m0, 2); p1[2] = dsa_msk(p1[2], m1, 2); \
            p0[3] = dsa_msk(p0[3], m0, 3); p1[3] = dsa_msk(p1[3], m1, 3); \
            p0[4] = dsa_msk(p0[4], m0, 8); p1[4] = dsa_msk(p1[4], m1, 8); \
            p0[5] = dsa_msk(p0[5], m0, 9); p1[5] = dsa_msk(p1[5], m1, 9); \
            p0[6] = dsa_msk(p0[6], m0, 10); p1[6] = dsa_msk(p1[6], m1, 10); \
            p0[7] = dsa_msk(p0[7], m0, 11); p1[7] = dsa_msk(p1[7], m1, 11); \
            p0[8] = dsa_msk(p0[8], m0, 16); p1[8] = dsa_msk(p1[8], m1, 16); \
            p0[9] = dsa_msk(p0[9], m0, 17); p1[9] = dsa_msk(p1[9], m1, 17); \
            p0[10] = dsa_msk(p0[10], m0, 18); p1[10] = dsa_msk(p1[10], m1, 18); \
            p0[11] = dsa_msk(p0[11], m0, 19); p1[11] = dsa_msk(p1[11], m1, 19); \
            p0[12] = dsa_msk(p0[12], m0, 24); p1[12] = dsa_msk(p1[12], m1, 24); \
            p0[13] = dsa_msk(p0[13], m0, 25); p1[13] = dsa_msk(p1[13], m1, 25); \
            p0[14] = dsa_msk(p0[14], m0, 26); p1[14] = dsa_msk(p1[14], m1, 26); \
            p0[15] = dsa_msk(p0[15], m0, 27); p1[15] = dsa_msk(p1[15], m1, 27); \
            float pmax = p0[0]; \
            _Pragma("unroll") for (int r = 1; r < 16; ++r) pmax = fmaxf(pmax, p0[r]); \
            _Pragma("unroll") for (int r = 0; r < 16; ++r) pmax = fmaxf(pmax, p1[r]); \
            pmax = fmaxf(pmax, other_half(pmax, hi)); \
            float mn, alpha; \
            if (__all((pmax - m_reg) * ATT_SCALE <= DSA_THR)) { mn = m_reg; alpha = 1.f; } \
            else { mn = fmaxf(m_reg, pmax); alpha = __builtin_amdgcn_exp2f((m_reg - mn) * C2); m_reg = mn; } \
            const float mnL = -mn * C2; \
            _Pragma("unroll") for (int r = 0; r < 16; ++r) { p0[r] = __builtin_amdgcn_exp2f(fmaf(p0[r], C2, mnL)); p1[r] = __builtin_amdgcn_exp2f(fmaf(p1[r], C2, mnL)); } \
            float ps = 0.f; \
            _Pragma("unroll") for (int r = 0; r < 16; ++r) ps += p0[r] + p1[r]; \
            ps += other_half(ps, hi); \
            l_reg = l_reg * alpha + ps; \
            if (__any(alpha < 1.f)) { if (hi == 0) al_l[r32] = alpha; LDS_WAIT(); \
                _Pragma("unroll") for (int r = 0; r < 16; ++r) { const float a_ = al_l[crow(r, hi)]; o[0][r] *= a_; o[1][r] *= a_; o[2][r] *= a_; o[3][r] *= a_; } } \
            bf16x8 pa0, pa1, pa2, pa3; pack_p(p0, p1, pa0, pa1, pa2, pa3); \
            pv_tile<BUF>(o, vb0, pa0, pa1, pa2, pa3); \
        } \
        if (has_next) mw = mw_next; \
        __syncthreads(); \
        ++it; if (it >= NT) break; }
        DS_BODY(0)
        DS_BODY(1)
#undef DS_BODY
    }
    if (hi == 0) li_l[r32] = l_reg; LDS_WAIT();
    float rli[16];
#pragma unroll
    for (int r = 0; r < 16; ++r) rli[r] = __builtin_amdgcn_rcpf(li_l[crow(r, hi)]);
    store_o(o, Y + (size_t)(b * SEQ + qlo) * DM + 1024 + h * 128, r32, hi, rli);
    __syncthreads();
#undef DS_LOAD
#undef DS_WRITE
}

__device__ __forceinline__ void cnt8v(int& a0, int& a1, int& a2, int& a3, unsigned k0, unsigned k1, unsigned k2, unsigned k3, unsigned k4, unsigned k5, unsigned k6, unsigned k7, unsigned cand) {
    asm volatile(
        "v_cmp_ge_u32_e64 s[36:37], %4, %12\n\t"
        "v_cmp_ge_u32_e64 s[38:39], %5, %12\n\t"
        "v_cmp_ge_u32_e64 s[40:41], %6, %12\n\t"
        "v_cmp_ge_u32_e64 s[42:43], %7, %12\n\t"
        "v_cmp_ge_u32_e64 s[44:45], %8, %12\n\t"
        "v_cmp_ge_u32_e64 s[46:47], %9, %12\n\t"
        "v_cmp_ge_u32_e64 s[48:49], %10, %12\n\t"
        "v_cmp_ge_u32_e64 s[50:51], %11, %12\n\t"
        "v_addc_co_u32_e64 %0, s[52:53], 0, %0, s[36:37]\n\t"
        "v_addc_co_u32_e64 %1, s[52:53], 0, %1, s[38:39]\n\t"
        "v_addc_co_u32_e64 %2, s[52:53], 0, %2, s[40:41]\n\t"
        "v_addc_co_u32_e64 %3, s[52:53], 0, %3, s[42:43]\n\t"
        "v_addc_co_u32_e64 %0, s[52:53], 0, %0, s[44:45]\n\t"
        "v_addc_co_u32_e64 %1, s[52:53], 0, %1, s[46:47]\n\t"
        "v_addc_co_u32_e64 %2, s[52:53], 0, %2, s[48:49]\n\t"
        "v_addc_co_u32_e64 %3, s[52:53], 0, %3, s[50:51]\n\t"
        : "+v"(a0), "+v"(a1), "+v"(a2), "+v"(a3)
        : "v"(k0), "v"(k1), "v"(k2), "v"(k3), "v"(k4), "v"(k5), "v"(k6), "v"(k7), "v"(cand)
        : "s36", "s37", "s38", "s39", "s40", "s41", "s42", "s43", "s44", "s45", "s46", "s47", "s48", "s49", "s50", "s51", "s52", "s53");
}
__device__ __forceinline__ void idxsel_pair(const GAS bf16_t* proj, const GAS bf16_t* kix, GAS unsigned long long* maskw, int b, int t0, int lane, LAS unsigned* kl  ) {
    asm volatile("" : "+v"(lane));
    const int r32 = lane & 31, hi = lane >> 5, t = t0 + hi;
    GAS unsigned long long* mrow = maskw + (size_t)(b * SEQ + t) * 32 + r32;
    if (t0 + 1 < 255) {
        const int lo = 64 * r32; *mrow = (t >= lo + 63) ? ~0ull : (t < lo ? 0ull : ((2ull << (t - lo)) - 1ull));
        return;
    }
    const int NKT = (t0 >> 5) + 1, NG = (NKT + 3) >> 2;
    {
        const int tl = (r32 >> 2) & 1, hh = 4 * (r32 >> 3) + (r32 & 3);
        bf16x8 af[4]; float wf[16];
        const GAS bf16_t* ap = proj + (size_t)(b * SEQ + t0 + tl) * LDP + C_QI + hh * 64 + hi * 8;
#pragma unroll
        for (int ks = 0; ks < 4; ++ks) af[ks] = *(const GAS bf16x8*)(ap + ks * 16);
        const GAS bf16_t* wp = proj + (size_t)(b * SEQ + t) * LDP + C_WI;
        const u32x4 w0 = *(const GAS u32x4*)wp, w1 = *(const GAS u32x4*)(wp + 8);
#pragma unroll
        for (int q = 0; q < 4; ++q) { wf[2 * q] = bf_lo(w0[q]); wf[2 * q + 1] = bf_hi(w0[q]); wf[8 + 2 * q] = bf_lo(w1[q]); wf[8 + 2 * q + 1] = bf_hi(w1[q]); }
        const GAS bf16_t* kp = kix + (size_t)b * (SEQ / 32) * 2048 + lane * 8;
        bf16x8 bc[4], bn[4];
#pragma unroll
        for (int ks = 0; ks < 4; ++ks) bc[ks] = *(const GAS bf16x8*)(kp + ks * 512);
        for (int g = 0; g < NG; ++g) {
            u32x4 kq = {0u, 0u, 0u, 0u};
#pragma unroll
            for (int i = 0; i < 4; ++i) {
                const int kt = 4 * g + i;
                if (kt < NKT) {
                    const bool more = (kt + 1 < NKT);
                    if (more) {
#pragma unroll
                        for (int ks = 0; ks < 4; ++ks) bn[ks] = *(const GAS bf16x8*)(kp + (size_t)(kt + 1) * 2048 + ks * 512);
                    }
                    f32x16 acc = {};
#pragma unroll
                    for (int ks = 0; ks < 4; ++ks) acc = __builtin_amdgcn_mfma_f32_32x32x16_bf16(af[ks], bc[ks], acc, 0, 0, 0);
                    float sc = 0.f;
#pragma unroll
                    for (int r = 0; r < 16; ++r) sc = fmaf(wf[r], fmaxf(acc[r], 0.f), sc);
                    const unsigned u = __float_as_uint(sc);
                    unsigned kv = (u >> 31) ? ~u : (u | 0x80000000u);
                    if (32 * kt + r32 > t) kv = 0u;
                    kq[i] = kv;
                    if (more) {
#pragma unroll
                        for (int ks = 0; ks < 4; ++ks) bc[ks] = bn[ks];
                    }
                }
            }
            *(LAS u32x4*)(kl + (g * 64 + lane) * 4) = kq;
        }
    }
    LDS_WAIT(); asm volatile("" ::: "memory");
    unsigned key[64];
#pragma unroll
    for (int g = 0; g < 16; ++g) { u32x4 kq = {0u, 0u, 0u, 0u}; if (g < NG) kq = *(const LAS u32x4*)(kl + (g * 64 + lane) * 4);
        key[4 * g] = kq[0]; key[4 * g + 1] = kq[1]; key[4 * g + 2] = kq[2]; key[4 * g + 3] = kq[3]; }
    unsigned T = 0u; bool done = false;
    for (int bit = 31; bit >= 0; --bit) {
        const unsigned cand = T | (1u << bit);
        int c0 = 0, c1 = 0, c2 = 0, c3 = 0;
#pragma unroll
        for (int g = 0; g < 8; ++g) { if (g * 8 < NKT) cnt8v(c0, c1, c2, c3, key[8 * g], key[8 * g + 1], key[8 * g + 2], key[8 * g + 3], key[8 * g + 4], key[8 * g + 5], key[8 * g + 6], key[8 * g + 7], cand); }
        int x = (c0 + c1) + (c2 + c3);
        x += __builtin_amdgcn_update_dpp(0, x, 0xB1, 0xf, 0xf, false);
        x += __builtin_amdgcn_update_dpp(0, x, 0x4E, 0xf, 0xf, false);
        x += __builtin_amdgcn_update_dpp(0, x, 0x141, 0xf, 0xf, false);
        x += __builtin_amdgcn_update_dpp(0, x, 0x140, 0xf, 0xf, false);
        const int q0 = __builtin_amdgcn_readlane(x, 0) + __builtin_amdgcn_readlane(x, 16), q1 = __builtin_amdgcn_readlane(x, 32) + __builtin_amdgcn_readlane(x, 48);
        const int cnt = hi ? q1 : q0;
        if (!done && cnt >= 256) T = cand;
        done = done || (cnt == 256);
        if (__all(done)) break;
    }
    unsigned lo_w = 0u, hi_w = 0u;
#pragma unroll
    for (int j = 0; j < 32; ++j) {
        if (2 * j < NKT) {
            const unsigned long long b0 = __ballot(key[2 * j] >= T && key[2 * j] != 0u), b1 = __ballot(key[2 * j + 1] >= T && key[2 * j + 1] != 0u);
            const unsigned a_lo = hi ? (unsigned)(b0 >> 32) : (unsigned)b0, a_hi = hi ? (unsigned)(b1 >> 32) : (unsigned)b1;
            lo_w = (r32 == j) ? a_lo : lo_w; hi_w = (r32 == j) ? a_hi : hi_w;
        }
    }
    *mrow = (unsigned long long)lo_w | ((unsigned long long)hi_w << 32);
}

constexpr int RING_BYTES = 131072, LDSCTL_OFF = RING_BYTES, MISC_OFF = LDSCTL_OFF + 320, LDS_BYTES = 147456;
constexpr int NPHASE = 2 + 11 * DEPTH + 1;
constexpr int CW_BAR = 4096;
static_assert((CW_BAR + NPHASE * XCD_BAR_WORDS) * 4 <= (int)CTL_BYTES, "ctl");

struct Args { const float* in[16]; float* out; unsigned char* ws; int ph_lo, ph_hi, li, pad; };

template <int MAP>
__device__ __forceinline__ int src_col(int n) {
    if (MAP == 0) return n;
    if (MAP == 2) { const int pn = n >> 8, bj = (n >> 7) & 1, cc = n & 127; return bj * DFF + pn * 128 + cc; }
    if (n < 3072) return n;
    if (n < 5120) { const int base = n & ~127, p = n & 127, g = p >> 3, j = p & 7; return base + ((j < 4) ? 4 * g + j : 64 + 4 * g + (j - 4)); }
    if (n < 6144) return n;
    if (n < 7168) { const int base = n & ~63, p = n & 63, g = p >> 3, j = p & 7; return base + ((j < 4) ? 4 * g + j : 32 + 4 * g + (j - 4)); }
    if (n < 9216) return 7248 + (n - 7168);
    if (n < 11264) return 9296 + (n - 9216);
    if (n < 11328) { const int p = n - 11264, g = p >> 3, j = p & 7; return 7168 + ((j < 4) ? 4 * g + j : 32 + 4 * g + (j - 4)); }
    if (n < 11344) return 7232 + (n - 11328);
    return -1;
}
template <int MAP>
__device__ __forceinline__ void convert_item(const GAS float* W, int Nsrc, GAS bf16_t* WT, int ldk, int kdst, int nblk, int item, int lane) {
    const int kb = item / nblk, nb = item % nblk, k0 = 32 * kb, n = 64 * nb + lane;
    const int sc_ = src_col<MAP>(n);
    const GAS float* wp = W + (size_t)k0 * Nsrc + (sc_ >= 0 ? sc_ : 0);
    float v[32];
#pragma unroll
    for (int i = 0; i < 32; ++i) v[i] = __builtin_nontemporal_load(wp + (size_t)i * Nsrc);
    if (sc_ < 0) {
#pragma unroll
        for (int i = 0; i < 32; ++i) v[i] = 0.f;
    }
    GAS u32x4* op = (GAS u32x4*)(WT + (size_t)n * ldk + kdst + k0);
#pragma unroll
    for (int g = 0; g < 4; ++g) { u32x4 o = {cvtpk(v[8 * g], v[8 * g + 1]), cvtpk(v[8 * g + 2], v[8 * g + 3]), cvtpk(v[8 * g + 4], v[8 * g + 5]), cvtpk(v[8 * g + 6], v[8 * g + 7])}; op[g] = o; }
}

typedef const __attribute__((address_space(4))) Args* KArgs;
__device__ __forceinline__ KArgs kargs() { KArgs k = (KArgs)__builtin_amdgcn_kernarg_segment_ptr(); asm volatile("" : "+s"(k)); return k; }
#define KIN(i) ((const GAS float*)kargs()->in[i])
#define WSP(T, off) ((GAS T*)((GAS unsigned char*)kargs()->ws + (off)))

template <bool COPY>
__device__ __forceinline__ void norm_rows(const GAS float* xsrc, const GAS float* gain, const GAS float* modb  ,
                                          GAS bf16_t* hb, GAS float* copy_to, int gw, int NGW, int lane) {
    for (int wv = gw; wv < NBATCH * 128; wv += NGW) {
        const int b = wv >> 7, rb = wv & 127;
        f32x4 gm[8], sh[8];
        { const GAS f32x4* gp = (const GAS f32x4*)gain + lane; const GAS f32x4* shp = (const GAS f32x4*)(modb + (size_t)b * NMOD) + lane; const GAS f32x4* scp = (const GAS f32x4*)(modb + (size_t)b * NMOD + DM) + lane;
#pragma unroll
          for (int j = 0; j < 8; ++j) { gm[j] = gp[64 * j] * (scp[64 * j] + 1.0f); sh[j] = shp[64 * j]; } }
        f32x4 cur[8], nxt[8];
        { const GAS f32x4* xr = (const GAS f32x4*)(xsrc + (size_t)(b * SEQ + rb) * DM) + lane;
#pragma unroll
          for (int j = 0; j < 8; ++j) cur[j] = __builtin_nontemporal_load(xr + 64 * j); }
        for (int k = 0; k < 16; ++k) {
            const int row = b * SEQ + rb + 128 * k;
            if (k + 1 < 16) { const GAS f32x4* xr = (const GAS f32x4*)(xsrc + (size_t)(row + 128) * DM) + lane;
#pragma unroll
                for (int j = 0; j < 8; ++j) nxt[j] = __builtin_nontemporal_load(xr + 64 * j); }
            float ss = 0.f;
#pragma unroll
            for (int j = 0; j < 8; ++j) ss += (cur[j][0] * cur[j][0] + cur[j][1] * cur[j][1]) + (cur[j][2] * cur[j][2] + cur[j][3] * cur[j][3]);
            const float rs = 1.f / sqrtf(wave_sum(ss) * (1.f / DM) + NORM_EPS);
            GAS u32x2* op = (GAS u32x2*)(hb + (size_t)row * DM) + lane;
#pragma unroll
            for (int j = 0; j < 8; ++j) {
                const f32x4 hv = cur[j] * rs * gm[j] + sh[j];
                u32x2 o2; o2.x = cvtpk(hv[0], hv[1]); o2.y = cvtpk(hv[2], hv[3]); op[64 * j] = o2;
                if (COPY) ((GAS f32x4*)(copy_to + (size_t)row * DM) + lane)[64 * j] = cur[j];
            }
#pragma unroll
            for (int j = 0; j < 8; ++j) cur[j] = nxt[j];
        }
    }
}

__global__ void __launch_bounds__(512, 2) fwd(Args args) {
    extern __shared__ __attribute__((aligned(16))) unsigned char lds_raw[];
    LAS unsigned char* lds = (LAS unsigned char*)lds_raw;
    volatile LAS unsigned* MISC = (volatile LAS unsigned*)(lds + MISC_OFF);
    const int G = gridDim.x; const int bx = blockIdx.x;
    const int vcu = (G % 8 == 0) ? (bx % 8) * (G / 8) + bx / 8 : bx;
    const int NGW = G * 8;
#define PHASE_IDS() int tid = threadIdx.x; asm volatile("" : "+v"(tid)); const int lane = tid & 63, wave = __builtin_amdgcn_readfirstlane(tid >> 6); const int gw = vcu * 8 + wave; (void)lane; (void)gw

    { PHASE_IDS(); for (int u = tid; u < (LDS_BYTES - LDSCTL_OFF) / 4; u += 512) ((LAS unsigned*)(lds + LDSCTL_OFF))[u] = 0u; }
    __syncthreads();
    const int lo = args.ph_lo, hi_ph = args.ph_hi;
    XcdBarrier bar; bar.bar = (unsigned*)(args.ws + WS_CTL) + CW_BAR + args.li * XCD_BAR_WORDS; bar.x = 0; bar.st = nullptr;
    if (hi_ph - lo > 1) bar = xcd_barrier_post((unsigned*)(args.ws + WS_CTL) + CW_BAR + args.li * XCD_BAR_WORDS, MISC + 8);
#ifndef AUDIT_MASK
#define AUDIT_MASK 0xFFFF
#endif
#define PH_ON(s) ((AUDIT_MASK >> (s)) & 1)
#define IN(k) (lo <= (k) && (k) < hi_ph)
#define SEAM(k) do { if (IN(k) && IN((k) + 1)) xcd_barrier(bar); } while (0)

    if (PH_ON(0) && IN(0)) {
            PHASE_IDS();
        const GAS float* c_in = KIN(1); const GAS int* positions = (const GAS int*)KIN(2); const GAS float* w_ada = KIN(7);
        GAS float* MODP = WSP(float, WS_ACT);
        LAS float* scl = (LAS float*)lds;
        for (int i0 = tid; i0 < NBATCH * DM; i0 += 512 * 16) {
            float cv_[16];
#pragma unroll
            for (int u = 0; u < 16; ++u) cv_[u] = c_in[i0 + u * 512];
#pragma unroll
            for (int u = 0; u < 16; ++u) { const int i = i0 + u * 512, b = i >> 11, k = i & (DM - 1); const float v = cv_[u]; scl[k * 16 + b] = v * fast_sigmoid(v); }
        }
        __syncthreads();
        for (int item = gw; item < DEPTH * 48 * 8; item += NGW) {
            const int kc = item & 7, rem = item >> 3, nb = rem % 48, l = rem / 48, n = nb * 256 + lane * 4;
            const GAS float* Wp = w_ada + ((size_t)l * DM + kc * 256) * NMOD + n;
            f32x4 acc[16];
#pragma unroll
            for (int b = 0; b < 16; ++b) acc[b] = (f32x4){0.f, 0.f, 0.f, 0.f};
            for (int k0 = 0; k0 < 256; k0 += 4, Wp += (size_t)4 * NMOD) {
                asm volatile("" : "+v"(Wp));
                f32x4 wv_[4];
#pragma unroll
                for (int u = 0; u < 4; ++u) wv_[u] = __builtin_nontemporal_load((const GAS f32x4*)(Wp + (size_t)u * NMOD));
#pragma unroll
                for (int u = 0; u < 4; ++u) {
                    const LAS f32x4* s4 = (const LAS f32x4*)(scl + (kc * 256 + k0 + u) * 16);
                    const f32x4 s0 = s4[0], s1 = s4[1], s2 = s4[2], s3 = s4[3];
#pragma unroll
                    for (int j = 0; j < 4; ++j) { acc[j] += wv_[u] * s0[j]; acc[4 + j] += wv_[u] * s1[j]; acc[8 + j] += wv_[u] * s2[j]; acc[12 + j] += wv_[u] * s3[j]; }
                }
            }
#pragma unroll
            for (int b = 0; b < 16; ++b) *(GAS f32x4*)(MODP + ((size_t)(kc * DEPTH + l) * 16 + b) * NMOD + n) = acc[b];
        }
        GAS float* COS128 = WSP(float, WS_COS128); GAS float* SIN128 = WSP(float, WS_SIN128); GAS float* COS64 = WSP(float, WS_COS64); GAS float* SIN64 = WSP(float, WS_SIN64);
        int pos_nx = positions[(bx * 512 + tid) / 96];
        for (int i = bx * 512 + tid; i < MTOK * 96; i += G * 512) {
            const int tok = i / 96, j = i % 96;
            const int pos_cur = pos_nx; { const int i2 = i + G * 512; if (i2 < MTOK * 96) pos_nx = positions[i2 / 96]; }
            const int e = (j < 64) ? j : 2 * (j - 64);
            double inv = 1.0, p = 0.8659643233600653;
            for (int q = 0; q < 6; ++q) { if ((e >> q) & 1) inv *= p; p *= p; }
            const double ang = (double)pos_cur * inv;
            const double kq = __builtin_rint(ang * 0.6366197723675814);
            double r = __builtin_fma(-kq, 1.5707963267948966, ang); r = __builtin_fma(-kq, 6.123233995736766e-17, r);
            const double r2 = r * r;
            double sn = -1.0 / 1307674368000.0; sn = sn * r2 + 1.0 / 6227020800.0; sn = sn * r2 - 1.0 / 39916800.0; sn = sn * r2 + 1.0 / 362880.0; sn = sn * r2 - 1.0 / 5040.0; sn = sn * r2 + 1.0 / 120.0; sn = sn * r2 - 1.0 / 6.0; sn = sn * r2 * r + r;
            double cs = 1.0 / 20922789888000.0; cs = cs * r2 - 1.0 / 87178291200.0; cs = cs * r2 + 1.0 / 479001600.0; cs = cs * r2 - 1.0 / 3628800.0; cs = cs * r2 + 1.0 / 40320.0; cs = cs * r2 - 1.0 / 720.0; cs = cs * r2 + 1.0 / 24.0; cs = cs * r2 - 0.5; cs = cs * r2 + 1.0;
            const int qd = ((int)(long long)kq) & 3;
            const double cc = (qd == 0) ? cs : (qd == 1) ? -sn : (qd == 2) ? -cs : sn;
            const double ss = (qd == 0) ? sn : (qd == 1) ? cs : (qd == 2) ? -sn : -cs;
            if (j < 64) { COS128[(size_t)tok * 64 + j] = (float)cc; SIN128[(size_t)tok * 64 + j] = (float)ss; }
            else { COS64[(size_t)tok * 32 + (j - 64)] = (float)cc; SIN64[(size_t)tok * 32 + (j - 64)] = (float)ss; }
        }
        __syncthreads();
    }
    SEAM(0);
    if (PH_ON(1) && IN(1)) {
            PHASE_IDS();
        const GAS float* b_ada = KIN(8); const GAS float* MODP = WSP(float, WS_ACT); GAS float* MOD = WSP(float, WS_MOD);
        for (int i = bx * 512 + tid; i < DEPTH * 16 * NMOD; i += G * 512) {
            const int n = i % NMOD, l = i / (16 * NMOD);
            float s = b_ada[(size_t)l * NMOD + n];
#pragma unroll
            for (int kc = 0; kc < 8; ++kc) s += MODP[(size_t)kc * DEPTH * 16 * NMOD + i];
            MOD[i] = s;
        }
    }
    SEAM(1);

    for (int layer = 0; layer < DEPTH; ++layer) {
        const int pb = 2 + 11 * layer;
        if (PH_ON(2) && IN(pb + 0)) {
            PHASE_IDS();
            constexpr int I_IN = 64 * (LDP / 64), I_A = 32 * 32, I_O = 64 * 32, I_UP = 64 * (NUP / 64), I_DN = (DFF / 32) * 32;
            constexpr int I_DN_LATE = 4096;
            constexpr int NITEMS = I_IN + 2 * I_A + I_O + I_UP + I_DN - I_DN_LATE;
            for (int it = gw; it < NITEMS; it += NGW) {
                int r = it;
                if (r < I_IN) { convert_item<1>(KIN(3) + (size_t)layer * DM * IN_W, IN_W, WSP(bf16_t, WS_WIN), DM, 0, LDP / 64, r, lane); continue; } r -= I_IN;
                if (r < I_A) { convert_item<0>(KIN(4) + (size_t)layer * 1024 * DM, DM, WSP(bf16_t, WS_WAB), DM, 0, 32, r, lane); continue; } r -= I_A;
                if (r < I_A) { convert_item<0>(KIN(5) + (size_t)layer * 1024 * DM, DM, WSP(bf16_t, WS_WAB), DM, 1024, 32, r, lane); continue; } r -= I_A;
                if (r < I_O) { convert_item<0>(KIN(6) + (size_t)layer * DM * DM, DM, WSP(bf16_t, WS_WO), DM, 0, 32, r, lane); continue; } r -= I_O;
                if (r < I_UP) { convert_item<2>(KIN(11) + (size_t)layer * DM * NUP, NUP, WSP(bf16_t, WS_WUP), DM, 0, NUP / 64, r, lane); continue; } r -= I_UP;
                convert_item<0>(KIN(14) + (size_t)layer * DFF * DM, DM, WSP(bf16_t, WS_WDN), DFF, 0, 32, r + I_DN_LATE, lane);
            }
            const GAS float* modl = WSP(float, WS_MOD) + (size_t)layer * 16 * NMOD;
            const GAS float* g_mix = KIN(9) + (size_t)layer * DM;
            GAS float* X = (GAS float*)kargs()->out; GAS bf16_t* HB = WSP(bf16_t, WS_HB);
            norm_rows<false>((layer == 0) ? KIN(0) : (const GAS float*)X, g_mix, modl, HB, nullptr, gw, NGW, lane);
            __syncthreads();
        }
        SEAM(pb + 0);
        if (PH_ON(3) && IN(pb + 1)) {
            pg8::Gemm g{WSP(bf16_t, WS_HB), WSP(bf16_t, WS_WIN), MTOK, LDP, DM}; pg8::StaticOrder S; S.init(MTOK, LDP, G, bx);
            EpiInProj E{WSP(bf16_t, WS_PROJ), WSP(float, WS_COS128), WSP(float, WS_SIN128), WSP(float, WS_COS64), WSP(float, WS_SIN64), WSP(bf16_t, WS_ACT)};
            pg8::gemm_phase<EpiInProj, pg8::StaticOrder, true, true>(lds, g, S, E);
            if (bx >= G / 2) { PHASE_IDS(); for (int r = (bx - G / 2) * 8 + wave; r < 4096; r += (G - G / 2) * 8) convert_item<0>(KIN(14) + (size_t)layer * DFF * DM, DM, WSP(bf16_t, WS_WDN), DFF, 0, 32, r, lane); }
        }
        SEAM(pb + 1);
        if (PH_ON(4) && IN(pb + 2)) {
            const GAS bf16_t* PROJ = WSP(bf16_t, WS_PROJ);
            { PHASE_IDS(); GAS unsigned long long* MK = WSP(unsigned long long, WS_MASK);
              for (int idx = gw; idx < MTOK / 2; idx += NGW) { const int b = idx >> 10, tp = ((idx & 1023) + 131 * (idx / NGW)) & 1023;
                  idxsel_pair(PROJ, WSP(bf16_t, WS_ACT), MK, b, 2 * tp, lane, (LAS unsigned*)(lds + wave * 16384)); }
              __syncthreads(); }
            for (int P = bx; P < 512; P += G) {
                const int bh = P >> 2, y = P & 3;
                sb_attn_unit((LAS char*)lds, PROJ, WSP(bf16_t, WS_Y), bh >> 3, bh & 7, y);
                sb_attn_unit((LAS char*)lds, PROJ, WSP(bf16_t, WS_Y), bh >> 3, bh & 7, 7 - y);
            }
        }
        SEAM(pb + 2);
        if (PH_ON(6) && IN(pb + 4)) {
            const GAS bf16_t* PROJ = WSP(bf16_t, WS_PROJ); const GAS unsigned long long* MK = WSP(unsigned long long, WS_MASK);
            for (int P = bx; P < 512; P += G) {
                const int bh = P >> 2, y = P & 3;
                dsa_attn_unit((LAS char*)lds, PROJ, MK, WSP(bf16_t, WS_Y), bh >> 3, bh & 7, y);
                dsa_attn_unit((LAS char*)lds, PROJ, MK, WSP(bf16_t, WS_Y), bh >> 3, bh & 7, 7 - y);
            }
        }
        SEAM(pb + 4);
        if (PH_ON(7) && IN(pb + 5)) {
            pg8::Gemm g{WSP(bf16_t, WS_Y), WSP(bf16_t, WS_WAB), MTOK, DM, DM}; pg8::StaticOrder S; S.init(MTOK, DM, G, bx);
            EpiGate E{WSP(bf16_t, WS_PROJ), WSP(bf16_t, WS_HB)};
            pg8::gemm_phase<EpiGate, pg8::StaticOrder, true, true>(lds, g, S, E);
        }
        SEAM(pb + 5);
        if (PH_ON(8) && IN(pb + 6)) {
            pg8::Gemm g{WSP(bf16_t, WS_HB), WSP(bf16_t, WS_WO), MTOK, DM, DM}; pg8::StaticOrder S; S.init(MTOK, DM, G, bx);
            EpiResid E{(GAS float*)kargs()->out, (layer == 0) ? KIN(0) : (const GAS float*)kargs()->out, WSP(float, WS_MOD) + (size_t)layer * 16 * NMOD + 2 * DM};
            pg8::gemm_phase<EpiResid, pg8::StaticOrder, true, true>(lds, g, S, E);
        }
        SEAM(pb + 6);
        if (PH_ON(9) && IN(pb + 7)) {
            PHASE_IDS();
            const GAS float* modl = WSP(float, WS_MOD) + (size_t)layer * 16 * NMOD;
            const GAS float* g_ffn = KIN(10) + (size_t)layer * DM;
            const GAS float* X = (const GAS float*)kargs()->out; GAS bf16_t* HB = WSP(bf16_t, WS_HB);
            norm_rows<false>(X, g_ffn, modl + 3 * DM, HB, nullptr, gw, NGW, lane);
        }
        SEAM(pb + 7);
        if (PH_ON(10) && IN(pb + 8)) {
            pg8::Gemm g{WSP(bf16_t, WS_HB), WSP(bf16_t, WS_WUP), MTOK, NUP, DM}; pg8::StaticOrder S; S.init(MTOK, NUP, G, bx);
            EpiConv E{WSP(bf16_t, WS_ACT), WSP(float, WS_H0), WSP(float, WS_H1), KIN(12) + (size_t)layer * 3 * NUP, KIN(13) + (size_t)layer * NUP, lds + RING_BYTES + 1024};
            pg8::gemm_phase<EpiConv, pg8::StaticOrder, true, true>(lds, g, S, E);
        }
        SEAM(pb + 8);
        if (PH_ON(11) && IN(pb + 9)) {
            PHASE_IDS();
            const GAS float* cw = KIN(12) + (size_t)layer * 3 * NUP; const GAS float* cb = KIN(13) + (size_t)layer * NUP;
            const GAS float* H0 = WSP(float, WS_H0); const GAS float* H1 = WSP(float, WS_H1); GAS bf16_t* ACT = WSP(bf16_t, WS_ACT);
            for (int item = bx * 512 + tid; item < 128 * 704; item += G * 512) {
                const int pm = item / 704, cg = item % 704, ch = cg * 8, pn = ch >> 7, cc = ch & 127;
                const bool first = (pm & 7) == 0;
                float um2[2][8], um1[2][8], u0[2][8], u1[2][8];
#pragma unroll
                for (int ab = 0; ab < 2; ++ab) {
                    const int col = pn * 256 + ab * 128 + cc;
#pragma unroll
                    for (int h = 0; h < 2; ++h) {
                        const f32x4 a0 = *(const GAS f32x4*)(H0 + ((size_t)pm * 2 + 0) * NUP + col + 4 * h), a1 = *(const GAS f32x4*)(H0 + ((size_t)pm * 2 + 1) * NUP + col + 4 * h);
                        f32x4 p2 = {0.f, 0.f, 0.f, 0.f}, p1 = {0.f, 0.f, 0.f, 0.f};
                        if (!first) { p2 = *(const GAS f32x4*)(H1 + ((size_t)(pm - 1) * 2 + 0) * NUP + col + 4 * h); p1 = *(const GAS f32x4*)(H1 + ((size_t)(pm - 1) * 2 + 1) * NUP + col + 4 * h); }
#pragma unroll
                        for (int j = 0; j < 4; ++j) { um2[ab][4 * h + j] = p2[j]; um1[ab][4 * h + j] = p1[j]; u0[ab][4 * h + j] = a0[j]; u1[ab][4 * h + j] = a1[j]; }
                    }
                }
                float o0[8], o1[8];
#pragma unroll
                for (int j = 0; j < 8; ++j) {
                    const float wa0 = cw[ch + j], wa1 = cw[NUP + ch + j], wa2 = cw[2 * NUP + ch + j], ba = cb[ch + j];
                    const float wb0 = cw[DFF + ch + j], wb1 = cw[NUP + DFF + ch + j], wb2 = cw[2 * NUP + DFF + ch + j], bb = cb[DFF + ch + j];
                    const float av0 = ba + wa0 * um2[0][j] + wa1 * um1[0][j] + wa2 * u0[0][j], bv0 = bb + wb0 * um2[1][j] + wb1 * um1[1][j] + wb2 * u0[1][j];
                    const float av1 = ba + wa0 * um1[0][j] + wa1 * u0[0][j] + wa2 * u1[0][j], bv1 = bb + wb0 * um1[1][j] + wb1 * u0[1][j] + wb2 * u1[1][j];
                    o0[j] = av0 * fast_sigmoid(av0) * bv0; o1[j] = av1 * fast_sigmoid(av1) * bv1;
                }
                u32x4 q0 = {cvtpk(o0[0], o0[1]), cvtpk(o0[2], o0[3]), cvtpk(o0[4], o0[5]), cvtpk(o0[6], o0[7])}, q1 = {cvtpk(o1[0], o1[1]), cvtpk(o1[2], o1[3]), cvtpk(o1[4], o1[5]), cvtpk(o1[6], o1[7])};
                *(GAS u32x4*)(ACT + (size_t)(pm * 256) * DFF + ch) = q0; *(GAS u32x4*)(ACT + (size_t)(pm * 256 + 1) * DFF + ch) = q1;
            }
        }
        SEAM(pb + 9);
        if (PH_ON(12) && IN(pb + 10)) {
            pg8::Gemm g{WSP(bf16_t, WS_ACT), WSP(bf16_t, WS_WDN), MTOK, DM, DFF}; pg8::StaticOrder S; S.init(MTOK, DM, G, bx);
            EpiResid E{(GAS float*)kargs()->out, (const GAS float*)kargs()->out, WSP(float, WS_MOD) + (size_t)layer * 16 * NMOD + 5 * DM};
            pg8::gemm_phase<EpiResid, pg8::StaticOrder, true, true>(lds, g, S, E);
        }
        SEAM(pb + 10);
    }

    if (PH_ON(13) && IN(NPHASE - 1)) {
            PHASE_IDS();
        GAS float* X = (GAS float*)kargs()->out; const GAS float* g_final = KIN(15);
        f32x4 gm[8];
#pragma unroll
        for (int j = 0; j < 8; ++j) gm[j] = ((const GAS f32x4*)g_final + lane)[64 * j];
        for (int wv = gw; wv < NBATCH * 128; wv += NGW) {
            const int b = wv >> 7, rb = wv & 127;
            f32x4 cur[8], nxt[8];
#pragma unroll
            for (int j = 0; j < 8; ++j) cur[j] = ((const GAS f32x4*)(X + (size_t)(b * SEQ + rb) * DM) + lane)[64 * j];
            for (int k = 0; k < 16; ++k) {
                const int row = b * SEQ + rb + 128 * k;
                if (k + 1 < 16) {
#pragma unroll
                    for (int j = 0; j < 8; ++j) nxt[j] = ((const GAS f32x4*)(X + (size_t)(row + 128) * DM) + lane)[64 * j]; }
                float ss = 0.f;
#pragma unroll
                for (int j = 0; j < 8; ++j) ss += (cur[j][0] * cur[j][0] + cur[j][1] * cur[j][1]) + (cur[j][2] * cur[j][2] + cur[j][3] * cur[j][3]);
                const float rs = 1.f / sqrtf(wave_sum(ss) * (1.f / DM) + NORM_EPS);
#pragma unroll
                for (int j = 0; j < 8; ++j) ((GAS f32x4*)(X + (size_t)row * DM) + lane)[64 * j] = cur[j] * rs * gm[j];
#pragma unroll
                for (int j = 0; j < 8; ++j) cur[j] = nxt[j];
            }
        }
    }
#undef IN
#undef SEAM
}

extern "C" void kernel_launch(void* const* d_in, const int* in_sizes, int n_in, void* d_out, int out_size, void* d_ws, size_t ws_size, hipStream_t stream) {
    static int grid = 0;
    if (grid == 0) {
        if (n_in != 16 || out_size != MTOK * DM || ws_size < WS_END) { fprintf(stderr, "kernel_launch: unexpected shapes (n_in %d out %d ws %zu)\n", n_in, out_size, ws_size); grid = -1; return; }
        int dev = 0, cus = 0, per_cu = 0;
        if (hipGetDevice(&dev) != hipSuccess || hipDeviceGetAttribute(&cus, hipDeviceAttributeMultiprocessorCount, dev) != hipSuccess) { grid = -1; return; }
        if (hipFuncSetAttribute((const void*)fwd, hipFuncAttributeMaxDynamicSharedMemorySize, LDS_BYTES) != hipSuccess) { fprintf(stderr, "kernel_launch: hipFuncSetAttribute failed\n"); grid = -1; return; }
        if (hipOccupancyMaxActiveBlocksPerMultiprocessor(&per_cu, (const void*)fwd, 512, LDS_BYTES) != hipSuccess || per_cu < 1) { fprintf(stderr, "kernel_launch: occupancy query says %d\n", per_cu); }
        (void)hipGetLastError();
        grid = cus;
    }
    if (grid < 0) return;
    (void)hipMemsetAsync((char*)d_ws + WS_CTL, 0, CTL_BYTES, stream);
    Args a{};
    for (int i = 0; i < 16; ++i) a.in[i] = (const float*)d_in[i];
    a.out = (float*)d_out; a.ws = (unsigned char*)d_ws;
#if MK_ONE_LAUNCH
    a.ph_lo = 0; a.ph_hi = NPHASE; a.li = 0;
    hipLaunchKernelGGL(fwd, dim3(grid), dim3(512), LDS_BYTES, stream, a);
#else
    for (int p = 0; p < NPHASE; ++p) { a.ph_lo = p; a.ph_hi = p + 1; a.li = p; hipLaunchKernelGGL(fwd, dim3(grid), dim3(512), LDS_BYTES, stream, a); }
#endif
}
```

```cpp
#include <hip/hip_runtime.h>
#include <cstdio>
#include <cstdint>

#ifndef MK_ONE_LAUNCH
#define MK_ONE_LAUNCH 1
#endif

#define LAS __attribute__((address_space(3)))
#define GAS __attribute__((address_space(1)))
typedef unsigned short bf16_t;
typedef short bf16x8 __attribute__((ext_vector_type(8)));
typedef short s16x4 __attribute__((ext_vector_type(4)));
typedef float f32x4 __attribute__((ext_vector_type(4)));
typedef float f32x16 __attribute__((ext_vector_type(16)));
typedef unsigned u32x4 __attribute__((ext_vector_type(4)));
typedef unsigned u32x2 __attribute__((ext_vector_type(2)));

constexpr int DM = 2048, NBATCH = 16, SEQ = 2048, DEPTH = 4, MTOK = NBATCH * SEQ;
constexpr int DFF = 5632, NUP = 2 * DFF, NMOD = 6 * DM;
constexpr int IN_W = 11344;
constexpr int LDP = 11520;
constexpr int C_QSB = 0, C_KSB = 1024, C_VSB = 2048, C_QD = 3072, C_KD = 4096, C_VD = 5120, C_QI = 6144, C_SA = 7168, C_SB = 9216, C_KI = 11264, C_WI = 11328;
constexpr float NORM_EPS = 1e-6f;

constexpr size_t MiB = 1u << 20;
constexpr size_t WS_CTL = 0, CTL_BYTES = 1 * MiB;
constexpr size_t WS_MOD = 1 * MiB;
constexpr size_t WS_COS128 = 4 * MiB, WS_SIN128 = 12 * MiB;
constexpr size_t WS_COS64 = 20 * MiB, WS_SIN64 = 24 * MiB;
constexpr size_t WS_MASK = 28 * MiB;
constexpr size_t WS_WIN = 36 * MiB;
constexpr size_t WS_WAB = 81 * MiB;
constexpr size_t WS_WO = 89 * MiB;
constexpr size_t WS_WUP = 97 * MiB;
constexpr size_t WS_WDN = 141 * MiB;
constexpr size_t WS_HB = 163 * MiB;
constexpr size_t WS_Y = 291 * MiB;
constexpr size_t WS_PROJ = 419 * MiB;
constexpr size_t WS_ACT = 1139 * MiB;
constexpr size_t WS_H0 = 1491 * MiB;
constexpr size_t WS_H1 = 1503 * MiB;
constexpr size_t WS_END = 1515 * MiB;

namespace pg8 {
constexpr int BM = 256, BK = 64, HALF = 128, HTB = HALF * BK * 2, STAGE_BYTES = 8 * HTB, NXCD = 8, WGM = 4;
__host__ __device__ __forceinline__ int lds_byte(int r, int c) { const int st = (r >> 4) * 2 + (c >> 5), rr = r & 15, cc = c & 31, ob = rr * 64 + cc * 2; return st * 1024 + (ob ^ (((ob >> 9) & 1) << 5)); }
__host__ __device__ __forceinline__ void stage_rc(int b, int& R, int& C) { const int st = b / 1024, sb = b % 1024, swz = sb ^ (((sb >> 9) & 1) << 5); R = (st >> 1) * 16 + swz / 64; C = (st & 1) * 32 + (swz % 64) / 2; }
__host__ __device__ __forceinline__ int perm32(int rho) { const int n = rho >> 4, i = rho & 15; return 8 * (i >> 2) + 4 * n + (i & 3); }
struct Unit { int pm, pn; };
struct Gemm { const GAS bf16_t* A; const GAS bf16_t* Bt; int M, N, K; };
struct StaticOrder {
    int nM, nN, nwg, G, c;
    __host__ __device__ void init(int M, int N, int G_, int c_) { nM = M / BM; nN = N / BM; nwg = nM * nN; G = G_; c = c_; }
    __host__ __device__ bool next(int i, Unit& u) const {
        const long L = (long)i * G + c; if (L >= nwg) return false;
        int wgid = (int)L; { const int q = nwg / NXCD, r = nwg % NXCD, xcd = wgid % NXCD, off = wgid / NXCD; wgid = (xcd < r ? xcd * (q + 1) : r * (q + 1) + (xcd - r) * q) + off; }
        const int nig = WGM * nN, gid = wgid / nig, fm = gid * WGM, gsz = (nM - fm) < WGM ? (nM - fm) : WGM;
        u.pm = fm + ((wgid % nig) % gsz); u.pn = (wgid % nig) / gsz; return true;
    }
    __device__ __forceinline__ void a_ready(const Unit&) const {}
    __device__ __forceinline__ void done(const Unit&) const {}
};

template <class Epi, class Sched, bool ALIGN_EPI = false, bool SP2 = false>
__device__ __forceinline__ void gemm_phase(LAS unsigned char* lds, const Gemm g, const Sched& S, const Epi& E) {
    int tid = threadIdx.x; asm volatile("" : "+v"(tid));
    const int wid = __builtin_amdgcn_readfirstlane(tid >> 6), lane = tid & 63, wr = wid >> 2, wc = wid & 3, fr = lane & 15, fq = lane >> 4;
    const int K = g.K, nt = K / BK;
    unsigned voffA[2], voffB[2];
#pragma unroll
    for (int i = 0; i < 2; ++i) { int R, C; stage_rc(tid * 16 + i * 8192, R, C); const int Rb = Epi::PERM ? ((R & ~31) + perm32(R & 31)) : R;
        voffA[i] = (unsigned)(R * K + C) * 2u; voffB[i] = (unsigned)(Rb * K + C) * 2u; }
    const size_t kstep = (size_t)(BK * 2);
    const size_t hstep = (size_t)HALF * K * 2;
    const size_t tstep = 2 * hstep;
    const unsigned ldsw = (unsigned)wid * 1024u;
    const int aoff = lds_byte(wr * 64 + fr, fq * 8), boff = lds_byte(wc * 32 + fr, fq * 8);
#define PG8_SA(b, h) (((b) * 2 + (h)) * HTB)
#define PG8_SB(b, h) ((4 + (b) * 2 + (h)) * HTB)
#define PG8_STAGE(bufoff, gbase, voff) do { _Pragma("unroll") for (int _i = 0; _i < 2; ++_i) \
        __builtin_amdgcn_global_load_lds((const GAS unsigned*)((const GAS char*)(gbase) + (voff)[_i]), (LAS unsigned*)(lds + (bufoff) + ldsw + _i * 8192), 16, 0, 0); } while (0)
#define PG8_LDA(dst, b, h) do { _Pragma("unroll") for (int m = 0; m < 4; ++m) _Pragma("unroll") for (int k = 0; k < 2; ++k) dst[m][k] = *(const LAS bf16x8*)(lds + PG8_SA(b, h) + aoff + m * 2048 + k * 1024); } while (0)
#define PG8_LDB(dst, b, h) do { _Pragma("unroll") for (int n = 0; n < 2; ++n) _Pragma("unroll") for (int k = 0; k < 2; ++k) dst[n][k] = *(const LAS bf16x8*)(lds + PG8_SB(b, h) + boff + n * 2048 + k * 1024); } while (0)
#define PG8_MMA(ai, bj, At, Bt) do { __builtin_amdgcn_s_setprio(1); _Pragma("unroll") for (int m = 0; m < 4; ++m) _Pragma("unroll") for (int n = 0; n < 2; ++n) _Pragma("unroll") for (int k = 0; k < 2; ++k) \
        acc[ai][bj][m][n] = __builtin_amdgcn_mfma_f32_16x16x32_bf16(Bt[n][k], At[m][k], acc[ai][bj][m][n], 0, 0, 0); __builtin_amdgcn_s_setprio(0); } while (0)
#define PG8_WAIT_V(n) asm volatile("s_waitcnt vmcnt(" #n ")" ::: "memory")
#define PG8_WAIT_L(n) asm volatile("s_waitcnt lgkmcnt(" #n ")" ::: "memory")
#define PG8_BAR __builtin_amdgcn_s_barrier()
#define PG8_SCHED __builtin_amdgcn_sched_barrier(0)
    Unit cur, nxt; int ui = 0;
    if (!S.next(0, cur)) return;
    f32x4 acc[2][2][4][2];
#pragma unroll
    for (int a = 0; a < 2; ++a)
#pragma unroll
        for (int b = 0; b < 2; ++b)
#pragma unroll
            for (int m = 0; m < 4; ++m)
#pragma unroll
                for (int n = 0; n < 2; ++n) acc[a][b][m][n] = (f32x4){0.f, 0.f, 0.f, 0.f};
    bf16x8 At[4][2], B0[2][2], B1[2][2];
    const GAS char* cA = (const GAS char*)g.A + (size_t)cur.pm * tstep; const GAS char* cB = (const GAS char*)g.Bt + (size_t)cur.pn * tstep;
    S.a_ready(cur);
    if constexpr (SP2) {
        PG8_STAGE(PG8_SB(0, 0), cB, voffB); PG8_STAGE(PG8_SB(0, 1), cB + hstep, voffB); PG8_STAGE(PG8_SA(0, 0), cA, voffA); PG8_STAGE(PG8_SA(0, 1), cA + hstep, voffA);
        if (wr == 1) PG8_BAR;
        PG8_WAIT_V(2); PG8_BAR;
        PG8_STAGE(PG8_SB(1, 0), cB + kstep, voffB); PG8_STAGE(PG8_SA(1, 0), cA + kstep, voffA); PG8_STAGE(PG8_SB(1, 1), cB + hstep + kstep, voffB);
        PG8_WAIT_V(6); PG8_BAR;
    } else {
        PG8_STAGE(PG8_SB(0, 0), cB, voffB); PG8_STAGE(PG8_SA(0, 0), cA, voffA); PG8_STAGE(PG8_SB(0, 1), cB + hstep, voffB); PG8_STAGE(PG8_SA(0, 1), cA + hstep, voffA);
        if (wr == 1) PG8_BAR;
        PG8_WAIT_V(4); PG8_BAR;
        PG8_STAGE(PG8_SB(1, 0), cB + kstep, voffB); PG8_STAGE(PG8_SA(1, 0), cA + kstep, voffA); PG8_STAGE(PG8_SB(1, 1), cB + hstep + kstep, voffB);
        PG8_WAIT_V(6); PG8_BAR;
    }
    for (;;) {
        const bool has_next = S.next(ui + 1, nxt);
        const GAS char* nA = has_next ? (const GAS char*)g.A + (size_t)nxt.pm * tstep : cA; const GAS char* nB = has_next ? (const GAS char*)g.Bt + (size_t)nxt.pn * tstep : cB;
        for (int t = 0; t < nt; t += 2) {
            const bool last = (t == nt - 2);
            const GAS char* a1 = cA + (size_t)(t + 1) * kstep;
            const GAS char* a2 = last ? nA : cA + (size_t)(t + 2) * kstep; const GAS char* b2 = last ? nB : cB + (size_t)(t + 2) * kstep;
            const GAS char* a3 = a2 + kstep; const GAS char* b3 = b2 + kstep;
            if (last && has_next) S.a_ready(nxt);
            if constexpr (Epi::HAS_MID) { if (t == (nt >> 1)) E.mid(acc, cur, wr, wc, fr, fq); }
            if constexpr (SP2) {
            PG8_LDB(B0, 0, 0); PG8_LDB(B1, 0, 1); PG8_SCHED; PG8_LDA(At, 0, 0); PG8_STAGE(PG8_SA(1, 1), a1 + hstep, voffA);
            PG8_WAIT_V(8); PG8_WAIT_L(0); PG8_BAR; PG8_MMA(0, 0, At, B0); PG8_MMA(0, 1, At, B1); PG8_BAR; PG8_SCHED;
            PG8_LDA(At, 0, 1); PG8_STAGE(PG8_SB(0, 0), b2, voffB); PG8_STAGE(PG8_SB(0, 1), b2 + hstep, voffB); PG8_STAGE(PG8_SA(0, 0), a2, voffA);
            PG8_WAIT_V(8); PG8_WAIT_L(0); PG8_BAR; PG8_MMA(1, 0, At, B0); PG8_MMA(1, 1, At, B1); PG8_BAR; PG8_SCHED;
            PG8_LDB(B0, 1, 0); PG8_LDB(B1, 1, 1); PG8_SCHED; PG8_LDA(At, 1, 0); PG8_STAGE(PG8_SA(0, 1), a2 + hstep, voffA);
            PG8_WAIT_V(8); PG8_WAIT_L(0); PG8_BAR; PG8_MMA(0, 0, At, B0); PG8_MMA(0, 1, At, B1); PG8_BAR; PG8_SCHED;
            PG8_LDA(At, 1, 1); PG8_STAGE(PG8_SB(1, 0), b3, voffB); PG8_STAGE(PG8_SB(1, 1), b3 + hstep, voffB); PG8_STAGE(PG8_SA(1, 0), a3, voffA);
            PG8_WAIT_V(8); PG8_WAIT_L(0); PG8_BAR; PG8_MMA(1, 0, At, B0); PG8_MMA(1, 1, At, B1); PG8_BAR; PG8_SCHED;
            } else {
            PG8_LDB(B0, 0, 0); PG8_SCHED; PG8_LDA(At, 0, 0); PG8_STAGE(PG8_SA(1, 1), a1 + hstep, voffA);
            PG8_WAIT_L(8); PG8_BAR; PG8_WAIT_L(0); PG8_MMA(0, 0, At, B0); PG8_BAR; PG8_SCHED;
            PG8_LDB(B1, 0, 1); PG8_STAGE(PG8_SB(0, 0), b2, voffB);
            PG8_BAR; PG8_WAIT_L(0); PG8_MMA(0, 1, At, B1); PG8_BAR;
            PG8_LDA(At, 0, 1); PG8_STAGE(PG8_SA(0, 0), a2, voffA);
            PG8_BAR; PG8_WAIT_L(0); PG8_MMA(1, 0, At, B0); PG8_BAR; PG8_SCHED;
            PG8_STAGE(PG8_SB(0, 1), b2 + hstep, voffB);
            PG8_WAIT_V(6); PG8_BAR; PG8_MMA(1, 1, At, B1); PG8_BAR;
            PG8_LDB(B0, 1, 0); PG8_SCHED; PG8_LDA(At, 1, 0); PG8_STAGE(PG8_SA(0, 1), a2 + hstep, voffA);
            PG8_WAIT_L(8); PG8_BAR; PG8_WAIT_L(0); PG8_MMA(0, 0, At, B0); PG8_BAR; PG8_SCHED;
            PG8_LDB(B1, 1, 1); PG8_STAGE(PG8_SB(1, 0), b3, voffB);
            PG8_BAR; PG8_WAIT_L(0); PG8_MMA(0, 1, At, B1); PG8_BAR;
            PG8_LDA(At, 1, 1); PG8_STAGE(PG8_SA(1, 0), a3, voffA);
            PG8_BAR; PG8_WAIT_L(0); PG8_MMA(1, 0, At, B0); PG8_BAR; PG8_SCHED;
            PG8_STAGE(PG8_SB(1, 1), b3 + hstep, voffB);
            PG8_WAIT_V(6); PG8_BAR; PG8_MMA(1, 1, At, B1); PG8_BAR;
            }
        }
        if constexpr (ALIGN_EPI) { if (wr == 0) PG8_BAR; }
        E(acc, cur, wr, wc, fr, fq); S.done(cur);
        if (!has_next) break;
#pragma unroll
        for (int a = 0; a < 2; ++a)
#pragma unroll
            for (int b = 0; b < 2; ++b)
#pragma unroll
                for (int m = 0; m < 4; ++m)
#pragma unroll
                    for (int n = 0; n < 2; ++n) acc[a][b][m][n] = (f32x4){0.f, 0.f, 0.f, 0.f};
        cur = nxt; cA = nA; cB = nB; ++ui;
        if constexpr (ALIGN_EPI) { if (wr == 1) PG8_BAR; }
    }
    PG8_WAIT_V(0);
    if constexpr (!ALIGN_EPI) { if (wr == 0) PG8_BAR; }
    PG8_BAR;
#undef PG8_SA
#undef PG8_SB
#undef PG8_STAGE
#undef PG8_LDA
#undef PG8_LDB
#undef PG8_MMA
#undef PG8_WAIT_V
#undef PG8_WAIT_L
#undef PG8_BAR
#undef PG8_SCHED
}
}

#define LDS_WAIT() asm volatile("s_waitcnt lgkmcnt(0)" ::: "memory")
#define VM_WAIT() asm volatile("s_waitcnt vmcnt(0)" ::: "memory")
#define SBAR() __builtin_amdgcn_sched_barrier(0)
typedef float f32x2 __attribute__((ext_vector_type(2)));
typedef __bf16 bf16x2_t __attribute__((ext_vector_type(2)));
__device__ __forceinline__ unsigned cvtpk(float lo, float hi) { const f32x2 v = {lo, hi}; return __builtin_bit_cast(unsigned, __builtin_convertvector(v, bf16x2_t)); }
__device__ __forceinline__ float bf_lo(unsigned w) { return __uint_as_float(w << 16); }
__device__ __forceinline__ float bf_hi(unsigned w) { return __uint_as_float(w & 0xffff0000u); }
__device__ __forceinline__ u32x4 pack8f(f32x4 a, f32x4 b) { u32x4 w = {cvtpk(a[0], a[1]), cvtpk(a[2], a[3]), cvtpk(b[0], b[1]), cvtpk(b[2], b[3])}; return w; }
__device__ __forceinline__ float wave_sum(float v) {
#pragma unroll
    for (int o = 1; o < 64; o <<= 1) v += __shfl_xor(v, o);
    return v;
}
__device__ __forceinline__ float fast_sigmoid(float v) { return __builtin_amdgcn_rcpf(1.f + __builtin_amdgcn_exp2f(-1.4426950408889634f * v)); }

#define XB_TMO      128
#define XB_XCNT(j)  (256  + 64 * (j))
#define XB_XSUB(j)  (1280 + 64 * (j))
#define XB_XGEN(j)  (2304 + 64 * (j))
#define XB_TOP      3328
#define XB_TOPGEN   3392
#define XCD_BAR_WORDS 3456
#define XB_SPIN_CAP (1u << 22)
__device__ __forceinline__ unsigned xb_ld(unsigned* p)              { return __hip_atomic_load(p, __ATOMIC_RELAXED, __HIP_MEMORY_SCOPE_AGENT); }
__device__ __forceinline__ unsigned xb_add(unsigned* p, unsigned v) { return __hip_atomic_fetch_add(p, v, __ATOMIC_RELAXED, __HIP_MEMORY_SCOPE_AGENT); }
__device__ __forceinline__ unsigned xb_xcc_id() { return (unsigned)__builtin_amdgcn_s_getreg((3 << 11) | 20) & 0xFu; }
#define XB_SPIN(cond, bar) do { unsigned _sp = 0; while (cond) { __builtin_amdgcn_s_sleep(1); \
    if ((++_sp & 255u) == 0u) { if (xb_ld(&(bar)[XB_TMO])) break; if (_sp > XB_SPIN_CAP) { atomicAdd(&(bar)[XB_TMO], 1u); break; } } } } while (0)
struct XcdBarrier { unsigned* bar; unsigned x; volatile LAS unsigned* st; };
__device__ __forceinline__ XcdBarrier xcd_barrier_post(unsigned* bar, volatile LAS unsigned* st) {
    XcdBarrier b; b.bar = bar; b.x = xb_xcc_id(); b.st = st;
    if (threadIdx.x == 0) (void)xb_add(&bar[XB_XCNT(b.x)], 1u);
    return b;
}
__device__ __forceinline__ void xcd_barrier_complete(unsigned* bar, unsigned x, unsigned& nloc, unsigned& nx) {
    const unsigned G = gridDim.x * gridDim.y * gridDim.z;
    unsigned sum, cnt, mine, sp = 0u;
    for (;;) {
        sum = 0u; cnt = 0u; mine = 0u;
#pragma unroll
        for (unsigned j = 0; j < 16; ++j) { const unsigned c = xb_ld(&bar[XB_XCNT(j)]); sum += c; cnt += (c > 0u) ? 1u : 0u; mine = (j == x) ? c : mine; }
        if (sum == G) break;
        __builtin_amdgcn_s_sleep(1);
        if ((++sp & 255u) == 0u) { if (xb_ld(&bar[XB_TMO])) break; if (sp > XB_SPIN_CAP) { atomicAdd(&bar[XB_TMO], 1u); break; } }
    }
    nloc = mine > 0u ? mine : 1u; nx = cnt > 0u ? cnt : 1u;
}
__device__ __forceinline__ void xcd_barrier(const XcdBarrier& b) {
    asm volatile("s_waitcnt vmcnt(0)" ::: "memory");
    __syncthreads();
    if (threadIdx.x == 0) {
        unsigned* bar = b.bar;
        __builtin_amdgcn_s_waitcnt(0);
        unsigned nloc = b.st[0], nx = b.st[1];
        if (nloc == 0u) { xcd_barrier_complete(bar, b.x, nloc, nx); b.st[0] = nloc; b.st[1] = nx; }
        const unsigned old = xb_add(&bar[XB_XSUB(b.x)], 1u);
        const unsigned gen = old / nloc;
        if (old + 1u == (gen + 1u) * nloc) {
            __builtin_amdgcn_fence(__ATOMIC_RELEASE, "agent");
            asm volatile("s_waitcnt vmcnt(0)" ::: "memory");
            const unsigned og = xb_add(&bar[XB_TOP], 1u);
            const unsigned tg = og / nx;
            if (og + 1u == (tg + 1u) * nx) xb_add(&bar[XB_TOPGEN], 1u);
            else XB_SPIN(xb_ld(&bar[XB_TOPGEN]) == tg, bar);
            __builtin_amdgcn_fence(__ATOMIC_ACQUIRE, "agent");
            xb_add(&bar[XB_XGEN(b.x)], 1u);
            asm volatile("s_waitcnt vmcnt(0)" ::: "memory");
        } else {
            XB_SPIN(xb_ld(&bar[XB_XGEN(b.x)]) == gen, bar);
            __builtin_amdgcn_fence(__ATOMIC_ACQUIRE, "agent");
            asm volatile("s_waitcnt vmcnt(0)" ::: "memory");
        }
    }
    __syncthreads();
}

using pg8::Unit;
struct EpiInProj {
    static constexpr bool PERM = true, HAS_MID = false;
    GAS bf16_t* O; const GAS float* cos128; const GAS float* sin128; const GAS float* cos64; const GAS float* sin64; GAS bf16_t* kix;
    template <int KIND>
    __device__ __forceinline__ void tile(const f32x4 (&acc)[2][2][4][2], const Unit& u, int wr, int wc, int fr, int fq) const {
        asm volatile("" : "+v"(fr), "+v"(fq));
        const int row0 = u.pm * 256 + wr * 64 + fr, col0 = u.pn * 256 + wc * 32 + 8 * fq;
#pragma unroll
        for (int ai = 0; ai < 2; ++ai) {
            f32x4 csv[4], snv[4];
#pragma unroll
            for (int m = 0; m < 4; ++m) { const int row = row0 + ai * 128 + m * 16;
                csv[m] = (f32x4){1.f, 1.f, 1.f, 1.f}; snv[m] = (f32x4){0.f, 0.f, 0.f, 0.f};
                if (KIND == 1) { csv[m] = *(const GAS f32x4*)(cos128 + (size_t)row * 64 + 16 * wc + 4 * fq); snv[m] = *(const GAS f32x4*)(sin128 + (size_t)row * 64 + 16 * wc + 4 * fq); }
                if (KIND == 2 || KIND == 4) { csv[m] = *(const GAS f32x4*)(cos64 + (size_t)row * 32 + 16 * (wc & 1) + 4 * fq); snv[m] = *(const GAS f32x4*)(sin64 + (size_t)row * 32 + 16 * (wc & 1) + 4 * fq); } }
#pragma unroll
            for (int m = 0; m < 4; ++m) {
                const int row = row0 + ai * 128 + m * 16;
                GAS bf16_t* rowp = O + (size_t)row * LDP + col0;
                const f32x4 cs = csv[m], sn = snv[m];
#pragma unroll
                for (int bj = 0; bj < 2; ++bj) {
                    f32x4 v0 = acc[ai][bj][m][0], v1 = acc[ai][bj][m][1];
                    bool rope = (KIND == 1 || KIND == 2);
                    if (KIND == 4) rope = (bj == 0 && wc < 2);
                    if (rope) { const f32x4 a = v0 * cs - v1 * sn, b = v1 * cs + v0 * sn; v0 = a; v1 = b; }
                    if (KIND == 3) {
#pragma unroll
                        for (int j = 0; j < 4; ++j) { v0[j] = fast_sigmoid(v0[j]); v1[j] = fast_sigmoid(v1[j]); }
                    }
                    *(GAS u32x4*)(rowp + bj * 128) = pack8f(v0, v1);
                    if (KIND == 4 && bj == 0 && wc < 2) {
                        const int g_ = 4 * wc + fq; *(GAS u32x4*)(kix + ((size_t)(row >> 5) * 4 + (g_ >> 1)) * 512 + (size_t)((row & 31) + 32 * (g_ & 1)) * 8) = pack8f(v0, v1); }
                }
            }
            asm volatile("" ::: "memory");
        }
    }
    __device__ __forceinline__ void operator()(const f32x4 (&acc)[2][2][4][2], const Unit& u, int wr, int wc, int fr, int fq) const {
        const int pn = u.pn;
        if (pn < 12 || (pn >= 20 && pn < 24)) tile<0>(acc, u, wr, wc, fr, fq);
        else if (pn < 20) tile<1>(acc, u, wr, wc, fr, fq);
        else if (pn < 28) tile<2>(acc, u, wr, wc, fr, fq);
        else if (pn < 44) tile<3>(acc, u, wr, wc, fr, fq);
        else tile<4>(acc, u, wr, wc, fr, fq);
    }
    __device__ __forceinline__ void mid(f32x4 (&)[2][2][4][2], const Unit&, int, int, int, int) const {}
};
struct EpiGate {
    static constexpr bool PERM = true, HAS_MID = true;
    const GAS bf16_t* P; GAS bf16_t* O;
    __device__ __forceinline__ void mid(f32x4 (&acc)[2][2][4][2], const Unit& u, int wr, int wc, int fr, int fq) const {
        asm volatile("" : "+v"(fr), "+v"(fq));
        const int row0 = u.pm * 256 + wr * 64 + fr, col0 = u.pn * 256 + wc * 32 + 8 * fq;
#pragma unroll
        for (int ai = 0; ai < 2; ++ai)
#pragma unroll
            for (int mp = 0; mp < 2; ++mp) {
                u32x4 sa[2][2], sb[2][2];
#pragma unroll
                for (int m2 = 0; m2 < 2; ++m2) { const GAS bf16_t* rowp = P + (size_t)(row0 + ai * 128 + (2 * mp + m2) * 16) * LDP + col0;
#pragma unroll
                    for (int bj = 0; bj < 2; ++bj) { sa[m2][bj] = *(const GAS u32x4*)(rowp + C_SA + bj * 128); sb[m2][bj] = *(const GAS u32x4*)(rowp + C_SB + bj * 128); } }
#pragma unroll
                for (int m2 = 0; m2 < 2; ++m2)
#pragma unroll
                    for (int bj = 0; bj < 2; ++bj)
#pragma unroll
                        for (int q = 0; q < 4; ++q) {
                            const float r0 = bf_lo(sa[m2][bj][q]) * __builtin_amdgcn_rcpf(fmaxf(bf_lo(sb[m2][bj][q]), 1e-30f));
                            const float r1 = bf_hi(sa[m2][bj][q]) * __builtin_amdgcn_rcpf(fmaxf(bf_hi(sb[m2][bj][q]), 1e-30f));
                            acc[ai][bj][2 * mp + m2][q >> 1][(q & 1) * 2 + 0] *= r0; acc[ai][bj][2 * mp + m2][q >> 1][(q & 1) * 2 + 1] *= r1;
                        }
                asm volatile("" ::: "memory");
            }
    }
    __device__ __forceinline__ void operator()(const f32x4 (&acc)[2][2][4][2], const Unit& u, int wr, int wc, int fr, int fq) const {
        asm volatile("" : "+v"(fr), "+v"(fq));
        const int row0 = u.pm * 256 + wr * 64 + fr, col0 = u.pn * 256 + wc * 32 + 8 * fq;
#pragma unroll
        for (int ai = 0; ai < 2; ++ai)
#pragma unroll
            for (int mp = 0; mp < 2; ++mp) {
                u32x4 sb[2][2];
#pragma unroll
                for (int m2 = 0; m2 < 2; ++m2)
#pragma unroll
                    for (int bj = 0; bj < 2; ++bj) sb[m2][bj] = *(const GAS u32x4*)(P + (size_t)(row0 + ai * 128 + (2 * mp + m2) * 16) * LDP + col0 + C_SB + bj * 128);
#pragma unroll
                for (int m2 = 0; m2 < 2; ++m2)
#pragma unroll
                    for (int bj = 0; bj < 2; ++bj) {
                        const int row = row0 + ai * 128 + (2 * mp + m2) * 16; const u32x4 w = sb[m2][bj];
                        f32x4 v0 = acc[ai][bj][2 * mp + m2][0], v1 = acc[ai][bj][2 * mp + m2][1];
                        v0[0] *= fmaxf(bf_lo(w[0]), 1e-30f); v0[1] *= fmaxf(bf_hi(w[0]), 1e-30f); v0[2] *= fmaxf(bf_lo(w[1]), 1e-30f); v0[3] *= fmaxf(bf_hi(w[1]), 1e-30f);
                        v1[0] *= fmaxf(bf_lo(w[2]), 1e-30f); v1[1] *= fmaxf(bf_hi(w[2]), 1e-30f); v1[2] *= fmaxf(bf_lo(w[3]), 1e-30f); v1[3] *= fmaxf(bf_hi(w[3]), 1e-30f);
                        *(GAS u32x4*)(O + (size_t)row * DM + col0 + bj * 128) = pack8f(v0, v1);
                    }
                asm volatile("" ::: "memory");
            }
    }
};
__device__ __forceinline__ float dpp_ror8f(float v) { return __builtin_bit_cast(float, __builtin_amdgcn_update_dpp(0, __builtin_bit_cast(int, v), 0x128, 0xf, 0xf, false)); }
__device__ __forceinline__ f32x4 dpp_ror8v(f32x4 v) { f32x4 r; r.x = dpp_ror8f(v.x); r.y = dpp_ror8f(v.y); r.z = dpp_ror8f(v.z); r.w = dpp_ror8f(v.w); return r; }
struct EpiResid {
    static constexpr bool PERM = false, HAS_MID = false;
    GAS float* X; const GAS float* Xin; const GAS float* gate;
    __device__ __forceinline__ void operator()(const f32x4 (&acc)[2][2][4][2], const Unit& u, int wr, int wc, int fr, int fq) const {
        asm volatile("" : "+v"(fr), "+v"(fq));
        const bool lo = fr < 8;
        const int col0 = u.pn * 256 + wc * 32 + 4 * fq;
        const int rowA = u.pm * 256 + wr * 64 + (fr & 7), colA = col0 + (lo ? 0 : 16);
        const GAS float* gp = gate + (size_t)(u.pm >> 3) * NMOD + col0;
        f32x4 gv[2][2];
#pragma unroll
        for (int bj = 0; bj < 2; ++bj)
#pragma unroll
            for (int n = 0; n < 2; ++n) gv[bj][n] = *(const GAS f32x4*)(gp + bj * 128 + n * 16);
        asm volatile("" : "+v"(gv[0][0]), "+v"(gv[0][1]), "+v"(gv[1][0]), "+v"(gv[1][1]));
#pragma unroll
        for (int bj = 0; bj < 2; ++bj)
#pragma unroll
            for (int n = 0; n < 2; ++n) gv[bj][n] = gv[bj][n] + 1.0f;
#pragma unroll
        for (int ai = 0; ai < 2; ++ai) {
            f32x4 xv[4][2][2];
#pragma unroll
            for (int m = 0; m < 4; ++m) { const GAS float* rowp = Xin + (size_t)(rowA + ai * 128 + m * 16) * DM + colA;
#pragma unroll
                for (int bj = 0; bj < 2; ++bj)
#pragma unroll
                    for (int h = 0; h < 2; ++h) xv[m][bj][h] = *(const GAS f32x4*)(rowp + (size_t)h * 8 * DM + bj * 128); }
#pragma unroll
            for (int m = 0; m < 4; ++m) { GAS float* rowp = X + (size_t)(rowA + ai * 128 + m * 16) * DM + colA;
#pragma unroll
                for (int bj = 0; bj < 2; ++bj) {
                    const f32x4 d0 = gv[bj][0] * acc[ai][bj][m][0], d1 = gv[bj][1] * acc[ai][bj][m][1];
                    const f32x4 rcv = dpp_ror8v(lo ? d1 : d0);
                    *(GAS f32x4*)(rowp + bj * 128) = xv[m][bj][0] + (lo ? d0 : rcv);
                    *(GAS f32x4*)(rowp + (size_t)8 * DM + bj * 128) = xv[m][bj][1] + (lo ? rcv : d1);
                }
            }
            asm volatile("" ::: "memory");
        }
    }
    __device__ __forceinline__ void mid(f32x4 (&)[2][2][4][2], const Unit&, int, int, int, int) const {}
};
#define DPP_SHR1 0x111
#define DPP_SHR2 0x112
#define DPP_ROR1 0x121
#define DPP_ROR2 0x122
__device__ __forceinline__ float dpp_prev1(float cur, float prv) {
    return __builtin_bit_cast(float, __builtin_amdgcn_update_dpp(__builtin_amdgcn_update_dpp(0, __builtin_bit_cast(int, prv), DPP_ROR1, 0xf, 0xf, false), __builtin_bit_cast(int, cur), DPP_SHR1, 0xf, 0xf, false)); }
__device__ __forceinline__ float dpp_prev2(float cur, float prv) {
    return __builtin_bit_cast(float, __builtin_amdgcn_update_dpp(__builtin_amdgcn_update_dpp(0, __builtin_bit_cast(int, prv), DPP_ROR2, 0xf, 0xf, false), __builtin_bit_cast(int, cur), DPP_SHR2, 0xf, 0xf, false)); }
struct EpiConv {
    static constexpr bool PERM = true, HAS_MID = false;
    GAS bf16_t* ACT; GAS float* H0; GAS float* H1; const GAS float* cw; const GAS float* cb; LAS unsigned char* ex;
    __device__ __forceinline__ void operator()(const f32x4 (&acc)[2][2][4][2], const Unit& u, int wr, int wc, int fr, int fq) const {
        asm volatile("" : "+v"(fr), "+v"(fq));
        const int row0 = u.pm * 256 + wr * 64 + fr, chl = wc * 32 + 8 * fq, ch0 = u.pn * 128 + chl;
        f32x4 w0[2][2], w1[2][2], w2[2][2], bs[2][2];
#pragma unroll
        for (int bj = 0; bj < 2; ++bj)
#pragma unroll
            for (int n = 0; n < 2; ++n) { const int c = bj * DFF + ch0 + 4 * n;
                w0[bj][n] = *(const GAS f32x4*)(cw + c); w1[bj][n] = *(const GAS f32x4*)(cw + NUP + c); w2[bj][n] = *(const GAS f32x4*)(cw + 2 * NUP + c); bs[bj][n] = *(const GAS f32x4*)(cb + c); }
        const int slot_l = ((wc * 4 + fq) * 2) * 16;
#pragma unroll
        for (int ai = 0; ai < 2; ++ai) { const int Q = 2 * ai + wr;
            if (Q < 3 && fr >= 14) {
#pragma unroll
                for (int bj = 0; bj < 2; ++bj)
#pragma unroll
                    for (int n = 0; n < 2; ++n) *(LAS f32x4*)(ex + Q * 2048 + (fr - 14) * 1024 + bj * 512 + slot_l + n * 16) = acc[ai][bj][3][n]; } }
        if (wr == 0 && fr < 2) {
#pragma unroll
            for (int bj = 0; bj < 2; ++bj)
#pragma unroll
                for (int n = 0; n < 2; ++n) *(GAS f32x4*)(H0 + ((size_t)u.pm * 2 + fr) * NUP + u.pn * 256 + bj * 128 + chl + 4 * n) = acc[0][bj][0][n]; }
        if (wr == 1 && fr >= 14) {
#pragma unroll
            for (int bj = 0; bj < 2; ++bj)
#pragma unroll
                for (int n = 0; n < 2; ++n) *(GAS f32x4*)(H1 + ((size_t)u.pm * 2 + (fr - 14)) * NUP + u.pn * 256 + bj * 128 + chl + 4 * n) = acc[1][bj][3][n]; }
        asm volatile("s_waitcnt lgkmcnt(0)" ::: "memory");
        __builtin_amdgcn_s_barrier();
        asm volatile("" ::: "memory");
#pragma unroll
        for (int ai = 0; ai < 2; ++ai) {
            const int Q = 2 * ai + wr;
            f32x4 pv[2][2];
#pragma unroll
            for (int bj = 0; bj < 2; ++bj)
#pragma unroll
                for (int n = 0; n < 2; ++n) { pv[bj][n] = (f32x4){0.f, 0.f, 0.f, 0.f};
                    if (Q > 0 && fr >= 14) pv[bj][n] = *(const LAS f32x4*)(ex + (Q - 1) * 2048 + (fr - 14) * 1024 + bj * 512 + slot_l + n * 16); }
#pragma unroll
            for (int m = 0; m < 4; ++m) {
                f32x4 cv[2][2];
#pragma unroll
                for (int bj = 0; bj < 2; ++bj)
#pragma unroll
                    for (int n = 0; n < 2; ++n) {
                        const f32x4 cur = acc[ai][bj][m][n]; const f32x4 prv = (m == 0) ? pv[bj][n] : acc[ai][bj][m > 0 ? m - 1 : 0][n];
                        f32x4 p1, p2;
                        p1.x = dpp_prev1(cur.x, prv.x); p1.y = dpp_prev1(cur.y, prv.y); p1.z = dpp_prev1(cur.z, prv.z); p1.w = dpp_prev1(cur.w, prv.w);
                        p2.x = dpp_prev2(cur.x, prv.x); p2.y = dpp_prev2(cur.y, prv.y); p2.z = dpp_prev2(cur.z, prv.z); p2.w = dpp_prev2(cur.w, prv.w);
                        cv[bj][n] = bs[bj][n] + w0[bj][n] * p2 + w1[bj][n] * p1 + w2[bj][n] * cur;
                    }
                f32x4 o0, o1;
#pragma unroll
                for (int j = 0; j < 4; ++j) { o0[j] = cv[0][0][j] * fast_sigmoid(cv[0][0][j]) * cv[1][0][j]; o1[j] = cv[0][1][j] * fast_sigmoid(cv[0][1][j]) * cv[1][1][j]; }
                const int row = row0 + ai * 128 + m * 16;
                if (!(Q == 0 && m == 0 && fr < 2)) *(GAS u32x4*)(ACT + (size_t)row * DFF + ch0) = pack8f(o0, o1);
            }
        }
    }
    __device__ __forceinline__ void mid(f32x4 (&)[2][2][4][2], const Unit&, int, int, int, int) const {}
};
constexpr int KVBLK = 64, SHM_K = KVBLK * 128 * 2, SHM_V = SHM_K;
constexpr float ATT_SCALE = 0.08838834764831845f;
#define KSWZ(row, colB) ((row) * 256 + ((colB) ^ (((row) & 7) << 4)))
__device__ __forceinline__ int v_st(int k, int c) { const int kk = (k & ~0xC) | ((k & 4) << 1) | ((k & 8) >> 1); return ((kk >> 3) * 4 + (c >> 5)) * 512 + ((kk & 7) * 32 + (c & 31)) * 2; }
__device__ __forceinline__ int v_rd_base(int lane) { return ((lane & 3) << 3) | (((lane >> 2) & 3) << 6) | (((lane >> 4) & 1) << 5) | (((lane >> 5) & 1) << 8); }
constexpr int v_rd_off(int d0, int ks, int half) { return d0 * 512 + ks * 4096 + half * 2048; }
__device__ __forceinline__ int crow(int r, int hi) { return (r & 3) + 8 * (r >> 2) + 4 * hi; }
template <int KB>
__device__ __forceinline__ void qkt(f32x16& p0, f32x16& p1, const LAS char* K_lds, int r32, int hi, const bf16x8* qr) {
    p0 = f32x16{}; p1 = f32x16{};
    int ka[4];
#pragma unroll
    for (int dd = 0; dd < 4; ++dd) ka[dd] = (int)(uintptr_t)(K_lds + KB * SHM_K + KSWZ(r32, (dd * 16 + hi * 8) * 2));
    bf16x8 fa0, fa1, fb0, fb1, fc0, fc1;
#define KRD1(dst, d0, off) asm volatile("ds_read_b128 %0, %1 offset:%2" : "=&v"(dst) : "v"(ka[(d0) & 3]), "i"(((d0) >> 2) * 128 + (off)) : "memory")
#define KRD(S, d0) do { KRD1(S##0, d0, 0); KRD1(S##1, d0, 32 * 256); } while (0)
#define KMM(S, d0, n) do { asm volatile("s_waitcnt lgkmcnt(" #n ")" ::: "memory"); SBAR(); \
        p0 = __builtin_amdgcn_mfma_f32_32x32x16_bf16(S##0, qr[d0], p0, 0, 0, 0); p1 = __builtin_amdgcn_mfma_f32_32x32x16_bf16(S##1, qr[d0], p1, 0, 0, 0); SBAR(); } while (0)
    KRD(fa, 0); KRD(fb, 1);
    KRD(fc, 2); KMM(fa, 0, 4);
    KRD(fa, 3); KMM(fb, 1, 4);
    KRD(fb, 4); KMM(fc, 2, 4);
    KRD(fc, 5); KMM(fa, 3, 4);
    KRD(fa, 6); KMM(fb, 4, 4);
    KRD(fb, 7); KMM(fc, 5, 4);
    KMM(fa, 6, 2);
    KMM(fb, 7, 0);
#undef KMM
#undef KRD
#undef KRD1
}
template <int VB>
__device__ __forceinline__ void pv_tile(f32x16* o, int vb0, bf16x8 pa0, bf16x8 pa1, bf16x8 pa2, bf16x8 pa3) {
#define TRRD(dst, off) asm volatile("ds_read_b64_tr_b16 %0, %1 offset:%2" : "=&v"(dst) : "v"(vb0), "i"(off) : "memory")
#define PV_RD(S, d0) do { constexpr int b_ = VB * SHM_V + v_rd_off(d0, 0, 0); \
        TRRD(S##l0, b_); TRRD(S##h0, b_ + 2048); TRRD(S##l1, b_ + 4096); TRRD(S##h1, b_ + 6144); TRRD(S##l2, b_ + 8192); TRRD(S##h2, b_ + 10240); TRRD(S##l3, b_ + 12288); TRRD(S##h3, b_ + 14336); } while (0)
#define PV_MM(S, d0, n) do { asm volatile("s_waitcnt lgkmcnt(" #n ")" ::: "memory"); SBAR(); \
        o[d0] = __builtin_amdgcn_mfma_f32_32x32x16_bf16(pa0, (bf16x8){S##l0[0], S##l0[1], S##l0[2], S##l0[3], S##h0[0], S##h0[1], S##h0[2], S##h0[3]}, o[d0], 0, 0, 0);   \
        o[d0] = __builtin_amdgcn_mfma_f32_32x32x16_bf16(pa1, (bf16x8){S##l1[0], S##l1[1], S##l1[2], S##l1[3], S##h1[0], S##h1[1], S##h1[2], S##h1[3]}, o[d0], 0, 0, 0);   \
        o[d0] = __builtin_amdgcn_mfma_f32_32x32x16_bf16(pa2, (bf16x8){S##l2[0], S##l2[1], S##l2[2], S##l2[3], S##h2[0], S##h2[1], S##h2[2], S##h2[3]}, o[d0], 0, 0, 0);   \
        o[d0] = __builtin_amdgcn_mfma_f32_32x32x16_bf16(pa3, (bf16x8){S##l3[0], S##l3[1], S##l3[2], S##l3[3], S##h3[0], S##h3[1], S##h3[2], S##h3[3]}, o[d0], 0, 0, 0); SBAR(); } while (0)
    s16x4 Al0, Al1, Al2, Al3, Ah0, Ah1, Ah2, Ah3, Bl0, Bl1, Bl2, Bl3, Bh0, Bh1, Bh2, Bh3;
    PV_RD(A, 0); PV_RD(B, 1);
    PV_MM(A, 0, 8);
    PV_RD(A, 2); PV_MM(B, 1, 8);
    PV_RD(B, 3); PV_MM(A, 2, 8);
    PV_MM(B, 3, 0);
#undef PV_MM
#undef PV_RD
#undef TRRD
}
__device__ __forceinline__ void pack_p(const f32x16& p0, const f32x16& p1, bf16x8& pa0, bf16x8& pa1, bf16x8& pa2, bf16x8& pa3) {
#define PK4(P, B_, OUT) do { unsigned a0 = cvtpk(P[B_+0], P[B_+1]), a1 = cvtpk(P[B_+2], P[B_+3]);                          \
        unsigned b0 = cvtpk(P[B_+4], P[B_+5]), b1 = cvtpk(P[B_+6], P[B_+7]);                                             \
        auto r0 = __builtin_amdgcn_permlane32_swap(a0, b0, false, false); auto r1 = __builtin_amdgcn_permlane32_swap(a1, b1, false, false); \
        u32x4 w = {r0[0], r1[0], r0[1], r1[1]}; OUT = *reinterpret_cast<bf16x8*>(&w); } while (0)
    PK4(p0, 0, pa0); PK4(p0, 8, pa1); PK4(p1, 0, pa2); PK4(p1, 8, pa3);
#undef PK4
}
__device__ __forceinline__ float other_half(float x, int hi) {
    auto rr = __builtin_amdgcn_permlane32_swap(__float_as_uint(x), __float_as_uint(x), false, false);
    return __uint_as_float(hi ? rr[0] : rr[1]);
}

__device__ __forceinline__ void store_o(const f32x16* o, GAS bf16_t* Ow, int r32, int hi, const float* rscale  ) {
#pragma unroll
    for (int r = 0; r < 16; ++r) { const int orow = crow(r, hi);
#pragma unroll
        for (int d0 = 0; d0 < 4; ++d0) { const float v = rscale ? o[d0][r] * rscale[r] : o[d0][r];
            const float vn = __shfl_xor(v, 1);
            if ((r32 & 1) == 0) *(GAS unsigned*)(Ow + (size_t)orow * DM + d0 * 32 + r32) = cvtpk(v, vn); } }
}

constexpr int ATT_LDS_WS = 2 * SHM_V + 2 * SHM_K;
__device__ __forceinline__ void sb_attn_unit(LAS char* lds, const GAS bf16_t* proj, GAS bf16_t* Y, int b, int h, int qb) {
    int tid = threadIdx.x; asm volatile("" : "+v"(tid));
    const int wid = __builtin_amdgcn_readfirstlane(tid >> 6), lane = tid & 63, r32 = lane & 31, hi = lane >> 5;
    LAS char* V_lds = lds; LAS char* K_lds = lds + 2 * SHM_V;
    volatile LAS unsigned* flags = (volatile LAS unsigned*)(lds + ATT_LDS_WS + 8 * 256);
    const int q0 = qb * 256, qlo = q0 + wid * 32, trow = qlo + r32;
    const GAS bf16_t* Qp = proj + (size_t)(b * SEQ + q0) * LDP + C_QSB + h * 128;
    const GAS bf16_t* Kp = proj + (size_t)(b * SEQ) * LDP + C_KSB + h * 128;
    const GAS bf16_t* Vp = proj + (size_t)(b * SEQ) * LDP + C_VSB + h * 128;
    bf16x8 qr[8];
#pragma unroll
    for (int d0 = 0; d0 < 8; ++d0) qr[d0] = *(const GAS bf16x8*)(Qp + (size_t)(wid * 32 + r32) * LDP + d0 * 16 + hi * 8);
    const int NT = qb * 4 + 4;
    const int sr = tid >> 4, sc = (tid & 15) * 8, vst0 = v_st(sr, sc), vst1 = v_st(32 + sr, sc), kws = KSWZ(sr, sc * 2);
    const int vb0 = (int)(uintptr_t)V_lds + v_rd_base(lane);
    bf16x8 st_k0, st_k1, st_v0, st_v1;
#define SB_LOAD(k0) do { st_v0 = *(const GAS bf16x8*)(Vp + (size_t)((k0) + sr) * LDP + sc); st_v1 = *(const GAS bf16x8*)(Vp + (size_t)((k0) + 32 + sr) * LDP + sc); \
                         st_k0 = *(const GAS bf16x8*)(Kp + (size_t)((k0) + sr) * LDP + sc); st_k1 = *(const GAS bf16x8*)(Kp + (size_t)((k0) + 32 + sr) * LDP + sc); } while (0)
#define SB_WRITE(bf) do { *(LAS bf16x8*)(V_lds + (bf) * SHM_V + vst0) = st_v0; *(LAS bf16x8*)(V_lds + (bf) * SHM_V + vst1) = st_v1; \
                          *(LAS bf16x8*)(K_lds + (bf) * SHM_K + kws) = st_k0; *(LAS bf16x8*)(K_lds + (bf) * SHM_K + kws + 32 * 256) = st_k1; } while (0)
    f32x16 o[4] = {};
    float C = 0.f;
    SB_LOAD((NT - 1) * 64); VM_WAIT(); SB_WRITE(0);
    if (NT > 1) SB_LOAD((NT - 2) * 64);
    __syncthreads();
    int it = 0;
    constexpr float C2S = ATT_SCALE * 1.4426950408889634f;
    for (;;) {
#define SB_BODY(BUF) { \
        const int kb = (NT - 1 - it) * 64; const bool has_next = (it + 1 < NT); \
        if (has_next) { VM_WAIT(); SB_WRITE((BUF) ^ 1); } \
        if (it + 2 < NT) SB_LOAD(kb - 128); \
        if (kb < qlo + 31) { \
            f32x16 p0, p1; qkt<BUF>(p0, p1, K_lds, r32, hi, qr); \
            const int dq = trow - kb - 4 * hi; \
            float Lv[32]; \
            const bool diag = (kb + 63 >= qlo);            \
            _Pragma("unroll") for (int r = 0; r < 16; ++r) { const int c = (r & 3) + 8 * (r >> 2); \
                { const float z = p0[r] * C2S; const float L = fmaxf(z, 0.f) + __builtin_amdgcn_logf(1.f + __builtin_amdgcn_exp2f(-fabsf(z))); const bool v = c < dq; Lv[r] = v ? L : 0.f; p0[r] = z - L; } \
                { const float z = p1[r] * C2S; const float L = fmaxf(z, 0.f) + __builtin_amdgcn_logf(1.f + __builtin_amdgcn_exp2f(-fabsf(z))); const bool v = (c + 32) < dq; Lv[16 + r] = v ? L : 0.f; p1[r] = z - L; } } \
              \
            float T[8], Tb[8], S[8]; \
            _Pragma("unroll") for (int q = 0; q < 8; ++q) T[q] = (Lv[4 * q] + Lv[4 * q + 1]) + (Lv[4 * q + 2] + Lv[4 * q + 3]); \
            _Pragma("unroll") for (int q = 0; q < 8; ++q) Tb[q] = other_half(T[q], hi); \
            float run = C; \
            _Pragma("unroll") for (int q = 7; q >= 0; --q) { S[q] = run + (hi ? 0.f : Tb[q]); run += T[q] + Tb[q]; } \
            C = run; \
            _Pragma("unroll") for (int q = 0; q < 8; ++q) { \
                const float e3 = S[q], e2 = e3 + Lv[4 * q + 3], e1 = e2 + Lv[4 * q + 2], e0 = e1 + Lv[4 * q + 1]; \
                const int cb = (q & 3) * 8 + (q >> 2) * 32; \
                if (q < 4) { p0[4 * q + 0] = __builtin_amdgcn_exp2f(p0[4 * q + 0] - e0); p0[4 * q + 1] = __builtin_amdgcn_exp2f(p0[4 * q + 1] - e1); \
                             p0[4 * q + 2] = __builtin_amdgcn_exp2f(p0[4 * q + 2] - e2); p0[4 * q + 3] = __builtin_amdgcn_exp2f(p0[4 * q + 3] - e3); } \
                else { const int qq = q - 4; \
                             p1[4 * qq + 0] = __builtin_amdgcn_exp2f(p1[4 * qq + 0] - e0); p1[4 * qq + 1] = __builtin_amdgcn_exp2f(p1[4 * qq + 1] - e1); \
                             p1[4 * qq + 2] = __builtin_amdgcn_exp2f(p1[4 * qq + 2] - e2); p1[4 * qq + 3] = __builtin_amdgcn_exp2f(p1[4 * qq + 3] - e3); } } \
            if (diag) { _Pragma("unroll") for (int r = 0; r < 16; ++r) { const int c = (r & 3) + 8 * (r >> 2); p0[r] = (c < dq) ? p0[r] : 0.f; p1[r] = ((c + 32) < dq) ? p1[r] : 0.f; } } \
            bf16x8 pa0, pa1, pa2, pa3; pack_p(p0, p1, pa0, pa1, pa2, pa3); \
            pv_tile<BUF>(o, vb0, pa0, pa1, pa2, pa3); \
        } \
        { const bool done = __all(C > 160.f); if (lane == 0) flags[(it & 1) * 8 + wid] = done ? 1u : 0u; } \
        __syncthreads(); \
        ++it; if (it >= NT) break; \
        { unsigned all = 1u; _Pragma("unroll") for (int w = 0; w < 8; ++w) all &= flags[((it - 1) & 1) * 8 + w]; if (all) break; } }
        SB_BODY(0)
        SB_BODY(1)
#undef SB_BODY
    }
    store_o(o, Y + (size_t)(b * SEQ + qlo) * DM + h * 128, r32, hi, nullptr);
    __syncthreads();
#undef SB_LOAD
#undef SB_WRITE
}

constexpr float DSA_THR = 8.f;
__device__ __forceinline__ float dsa_msk(float p, int m, int c) { const int s = __builtin_amdgcn_sbfe(m, c, 1); return __builtin_bit_cast(float, (__builtin_bit_cast(int, p) & s) | (~s & (int)0xFF800000)); }
__device__ __forceinline__ void dsa_attn_unit(LAS char* lds, const GAS bf16_t* proj, const GAS unsigned long long* maskw, GAS bf16_t* Y, int b, int h, int qb) {
    int tid = threadIdx.x; asm volatile("" : "+v"(tid));
    const int wid = __builtin_amdgcn_readfirstlane(tid >> 6), lane = tid & 63, r32 = lane & 31, hi = lane >> 5;
    LAS char* V_lds = lds; LAS char* K_lds = lds + 2 * SHM_V;
    LAS float* ws = (LAS float*)(lds + ATT_LDS_WS) + wid * 64; LAS float* li_l = ws; LAS float* al_l = ws + 32;
    const int q0 = qb * 256, qlo = q0 + wid * 32, trow = qlo + r32;
    const GAS bf16_t* Qp = proj + (size_t)(b * SEQ + q0) * LDP + C_QD + h * 128;
    const GAS bf16_t* Kp = proj + (size_t)(b * SEQ) * LDP + C_KD + h * 128;
    const GAS bf16_t* Vp = proj + (size_t)(b * SEQ) * LDP + C_VD + h * 128;
    const GAS unsigned long long* mrow = maskw + (size_t)(b * SEQ + trow) * 32;
    bf16x8 qr[8];
#pragma unroll
    for (int d0 = 0; d0 < 8; ++d0) qr[d0] = *(const GAS bf16x8*)(Qp + (size_t)(wid * 32 + r32) * LDP + d0 * 16 + hi * 8);
    const int NT = qb * 4 + 4;
    const int sr = tid >> 4, sc = (tid & 15) * 8, vst0 = v_st(sr, sc), vst1 = v_st(32 + sr, sc), kws = KSWZ(sr, sc * 2);
    const int vb0 = (int)(uintptr_t)V_lds + v_rd_base(lane);
    bf16x8 st_k0, st_k1, st_v0, st_v1;
#define DS_LOAD(k0) do { st_v0 = *(const GAS bf16x8*)(Vp + (size_t)((k0) + sr) * LDP + sc); st_v1 = *(const GAS bf16x8*)(Vp + (size_t)((k0) + 32 + sr) * LDP + sc); \
                         st_k0 = *(const GAS bf16x8*)(Kp + (size_t)((k0) + sr) * LDP + sc); st_k1 = *(const GAS bf16x8*)(Kp + (size_t)((k0) + 32 + sr) * LDP + sc); } while (0)
#define DS_WRITE(bf) do { *(LAS bf16x8*)(V_lds + (bf) * SHM_V + vst0) = st_v0; *(LAS bf16x8*)(V_lds + (bf) * SHM_V + vst1) = st_v1; \
                          *(LAS bf16x8*)(K_lds + (bf) * SHM_K + kws) = st_k0; *(LAS bf16x8*)(K_lds + (bf) * SHM_K + kws + 32 * 256) = st_k1; } while (0)
    f32x16 o[4] = {};
    float m_reg = -1e30f, l_reg = 0.f;
    unsigned long long mw = mrow[0], mw_next = 0ull;
    DS_LOAD(0); VM_WAIT(); DS_WRITE(0);
    if (NT > 1) DS_LOAD(64);
    __syncthreads();
    constexpr float C2 = 1.4426950408889634f * ATT_SCALE;
    int it = 0;
    for (;;) {
#define DS_BODY(BUF) { \
        const int kb = it * 64; const bool has_next = (it + 1 < NT); \
        if (has_next) { VM_WAIT(); DS_WRITE((BUF) ^ 1); mw_next = mrow[it + 1]; }        \
        if (it + 2 < NT) DS_LOAD(kb + 128); \
        if (kb <= qlo + 31) { \
            f32x16 p0, p1; qkt<BUF>(p0, p1, K_lds, r32, hi, qr); \
            const int m0 = (int)((unsigned)mw >> (4 * hi)), m1 = (int)((unsigned)(mw >> 32) >> (4 * hi)); \
              \
            p0[0] = dsa_msk(p0[0], m0, 0); p1[0] = dsa_msk(p1[0], m1, 0); \
            p0[1] = dsa_msk(p0[1], m0, 1); p1[1] = dsa_msk(p1[1], m1, 1); \
            p0[2] = dsa_msk(p0[2], m0, 2); p1[2] = dsa_msk(p1[2], m1, 2); \
            p0[3] = dsa_msk(p0[3], m0, 3); p1[3] = dsa_msk(p1[3], m1, 3); \
            p0[4] = dsa_msk(p0[4], m0, 8); p1[4] = dsa_msk(p1[4], m1, 8); \
            p0[5] = dsa_msk(p0[5], m0, 9); p1[5] = dsa_msk(p1[5], m1, 9); \
            p0[6] = dsa_msk(p0[6], m0, 10); p1[6] = dsa_msk(p1[6], m1, 10); \
            p0[7] = dsa_msk(p0[7], m0, 11); p1[7] = dsa_msk(p1[7], m1, 11); \
            p0[8] = dsa_msk(p0[8], m0, 16); p1[8] = dsa_msk(p1[8], m1, 16); \
            p0[9] = dsa_msk(p0[9], m0, 17); p1[9] = dsa_msk(p1[9], m1, 17); \
            p0[10] = dsa_msk(p0[10], m0, 18); p1[10] = dsa_msk(p1[10], m1, 18); \
            p0[11] = dsa_msk(p0[11], m0, 19); p1[11] = dsa_msk(p1[11], m1, 19); \
            p0[12] = dsa_msk(p0[12], m0, 24); p1[12] = dsa_msk(p1[12], m1, 24); \
            p0[13] = dsa_msk(p0[13], m0, 25); p1[13] = dsa_msk(p1[13], m1, 25); \
            p0[14] = dsa_msk(p0[14], m0, 26); p1[14] = dsa_msk(p1[14], m1, 26); \
            p0[15] = dsa_msk(p0[15], m0, 27); p1[15] = dsa_msk(p1[15], m1, 27); \
            float pmax = p0[0]; \
            _Pragma("unroll") for (int r = 1; r < 16; ++r) pmax = fmaxf(pmax, p0[r]); \
            _Pragma("unroll") for (int r = 0; r < 16; ++r) pmax = fmaxf(pmax, p1[r]); \
            pmax = fmaxf(pmax, other_half(pmax, hi)); \
            float mn, alpha; \
            if (__all((pmax - m_reg) * ATT_SCALE <= DSA_THR)) { mn = m_reg; alpha = 1.f; } \
            else { mn = fmaxf(m_reg, pmax); alpha = __builtin_amdgcn_exp2f((m_reg - mn) * C2); m_reg = mn; } \
            const float mnL = -mn * C2; \
            _Pragma("unroll") for (int r = 0; r < 16; ++r) { p0[r] = __builtin_amdgcn_exp2f(fmaf(p0[r], C2, mnL)); p1[r] = __builtin_amdgcn_exp2f(fmaf(p1[r], C2, mnL)); } \
            float ps = 0.f; \
            _Pragma("unroll") for (int r = 0; r < 16; ++r) ps += p0[r] + p1[r]; \
            ps += other_half(ps, hi); \
            l_reg = l_reg * alpha + ps; \
            if (__any(alpha < 1.f)) { if (hi == 0) al_l[r32] = alpha; LDS_WAIT(); \
                _Pragma("unroll") for (int r = 0; r < 16; ++r) { const float a_ = al_l[crow(r, hi)]; o[0][r] *= a_; o[1][r] *= a_; o[2][r] *= a_; o[3][r] *= a_; } } \
            bf16x8 pa0, pa1, pa2, pa3; pack_p(p0, p1, pa0, pa1, pa2, pa3); \
            pv_tile<BUF>(o, vb0, pa0, pa1, pa2, pa3); \
        } \
        if (has_next) mw = mw_next; \
        __syncthreads(); \
        ++it; if (it >= NT) break; }
        DS_BODY(0)
        DS_BODY(1)
#undef DS_BODY
    }
    if (hi == 0) li_l[r32] = l_reg; LDS_WAIT();
    float rli[16];
#pragma unroll
    for (int r = 0; r < 16; ++r) rli[r] = __builtin_amdgcn_rcpf(li_l[crow(r, hi)]);
    store_o(o, Y + (size_t)(b * SEQ + qlo) * DM + 1024 + h * 128, r32, hi, rli);
    __syncthreads();
#undef DS_LOAD
#undef DS_WRITE
}

__device__ __forceinline__ void cnt8v(int& a0, int& a1, int& a2, int& a3, unsigned k0, unsigned k1, unsigned k2, unsigned k3, unsigned k4, unsigned k5, unsigned k6, unsigned k7, unsigned cand) {
    asm volatile(
        "v_cmp_ge_u32_e64 s[36:37], %4, %12\n\t"
        "v_cmp_ge_u32_e64 s[38:39], %5, %12\n\t"
        "v_cmp_ge_u32_e64 s[40:41], %6, %12\n\t"
        "v_cmp_ge_u32_e64 s[42:43], %7, %12\n\t"
        "v_cmp_ge_u32_e64 s[44:45], %8, %12\n\t"
        "v_cmp_ge_u32_e64 s[46:47], %9, %12\n\t"
        "v_cmp_ge_u32_e64 s[48:49], %10, %12\n\t"
        "v_cmp_ge_u32_e64 s[50:51], %11, %12\n\t"
        "v_addc_co_u32_e64 %0, s[52:53], 0, %0, s[36:37]\n\t"
        "v_addc_co_u32_e64 %1, s[52:53], 0, %1, s[38:39]\n\t"
        "v_addc_co_u32_e64 %2, s[52:53], 0, %2, s[40:41]\n\t"
        "v_addc_co_u32_e64 %3, s[52:53], 0, %3, s[42:43]\n\t"
        "v_addc_co_u32_e64 %0, s[52:53], 0, %0, s[44:45]\n\t"
        "v_addc_co_u32_e64 %1, s[52:53], 0, %1, s[46:47]\n\t"
        "v_addc_co_u32_e64 %2, s[52:53], 0, %2, s[48:49]\n\t"
        "v_addc_co_u32_e64 %3, s[52:53], 0, %3, s[50:51]\n\t"
        : "+v"(a0), "+v"(a1), "+v"(a2), "+v"(a3)
        : "v"(k0), "v"(k1), "v"(k2), "v"(k3), "v"(k4), "v"(k5), "v"(k6), "v"(k7), "v"(cand)
        : "s36", "s37", "s38", "s39", "s40", "s41", "s42", "s43", "s44", "s45", "s46", "s47", "s48", "s49", "s50", "s51", "s52", "s53");
}
__device__ __forceinline__ void idxsel_pair(const GAS bf16_t* proj, const GAS bf16_t* kix, GAS unsigned long long* maskw, int b, int t0, int lane, LAS unsigned* kl  ) {
    asm volatile("" : "+v"(lane));
    const int r32 = lane & 31, hi = lane >> 5, t = t0 + hi;
    GAS unsigned long long* mrow = maskw + (size_t)(b * SEQ + t) * 32 + r32;
    if (t0 + 1 < 255) {
        const int lo = 64 * r32; *mrow = (t >= lo + 63) ? ~0ull : (t < lo ? 0ull : ((2ull << (t - lo)) - 1ull));
        return;
    }
    const int NKT = (t0 >> 5) + 1, NG = (NKT + 3) >> 2;
    {
        const int tl = (r32 >> 2) & 1, hh = 4 * (r32 >> 3) + (r32 & 3);
        bf16x8 af[4]; float wf[16];
        const GAS bf16_t* ap = proj + (size_t)(b * SEQ + t0 + tl) * LDP + C_QI + hh * 64 + hi * 8;
#pragma unroll
        for (int ks = 0; ks < 4; ++ks) af[ks] = *(const GAS bf16x8*)(ap + ks * 16);
        const GAS bf16_t* wp = proj + (size_t)(b * SEQ + t) * LDP + C_WI;
        const u32x4 w0 = *(const GAS u32x4*)wp, w1 = *(const GAS u32x4*)(wp + 8);
#pragma unroll
        for (int q = 0; q < 4; ++q) { wf[2 * q] = bf_lo(w0[q]); wf[2 * q + 1] = bf_hi(w0[q]); wf[8 + 2 * q] = bf_lo(w1[q]); wf[8 + 2 * q + 1] = bf_hi(w1[q]); }
        const GAS bf16_t* kp = kix + (size_t)b * (SEQ / 32) * 2048 + lane * 8;
        bf16x8 bc[4], bn[4];
#pragma unroll
        for (int ks = 0; ks < 4; ++ks) bc[ks] = *(const GAS bf16x8*)(kp + ks * 512);
        for (int g = 0; g < NG; ++g) {
            u32x4 kq = {0u, 0u, 0u, 0u};
#pragma unroll
            for (int i = 0; i < 4; ++i) {
                const int kt = 4 * g + i;
                if (kt < NKT) {
                    const bool more = (kt + 1 < NKT);
                    if (more) {
#pragma unroll
                        for (int ks = 0; ks < 4; ++ks) bn[ks] = *(const GAS bf16x8*)(kp + (size_t)(kt + 1) * 2048 + ks * 512);
                    }
                    f32x16 acc = {};
#pragma unroll
                    for (int ks = 0; ks < 4; ++ks) acc = __builtin_amdgcn_mfma_f32_32x32x16_bf16(af[ks], bc[ks], acc, 0, 0, 0);
                    float sc = 0.f;
#pragma unroll
                    for (int r = 0; r < 16; ++r) sc = fmaf(wf[r], fmaxf(acc[r], 0.f), sc);
                    const unsigned u = __float_as_uint(sc);
                    unsigned kv = (u >> 31) ? ~u : (u | 0x80000000u);
                    if (32 * kt + r32 > t) kv = 0u;
                    kq[i] = kv;
                    if (more) {
#pragma unroll
                        for (int ks = 0; ks < 4; ++ks) bc[ks] = bn[ks];
                    }
                }
            }
            *(LAS u32x4*)(kl + (g * 64 + lane) * 4) = kq;
        }
    }
    LDS_WAIT(); asm volatile("" ::: "memory");
    unsigned key[64];
#pragma unroll
    for (int g = 0; g < 16; ++g) { u32x4 kq = {0u, 0u, 0u, 0u}; if (g < NG) kq = *(const LAS u32x4*)(kl + (g * 64 + lane) * 4);
        key[4 * g] = kq[0]; key[4 * g + 1] = kq[1]; key[4 * g + 2] = kq[2]; key[4 * g + 3] = kq[3]; }
    unsigned T = 0u; bool done = false;
    for (int bit = 31; bit >= 0; --bit) {
        const unsigned cand = T | (1u << bit);
        int c0 = 0, c1 = 0, c2 = 0, c3 = 0;
#pragma unroll
        for (int g = 0; g < 8; ++g) { if (g * 8 < NKT) cnt8v(c0, c1, c2, c3, key[8 * g], key[8 * g + 1], key[8 * g + 2], key[8 * g + 3], key[8 * g + 4], key[8 * g + 5], key[8 * g + 6], key[8 * g + 7], cand); }
        int x = (c0 + c1) + (c2 + c3);
        x += __builtin_amdgcn_update_dpp(0, x, 0xB1, 0xf, 0xf, false);
        x += __builtin_amdgcn_update_dpp(0, x, 0x4E, 0xf, 0xf, false);
        x += __builtin_amdgcn_update_dpp(0, x, 0x141, 0xf, 0xf, false);
        x += __builtin_amdgcn_update_dpp(0, x, 0x140, 0xf, 0xf, false);
        const int q0 = __builtin_amdgcn_readlane(x, 0) + __builtin_amdgcn_readlane(x, 16), q1 = __builtin_amdgcn_readlane(x, 32) + __builtin_amdgcn_readlane(x, 48);
        const int cnt = hi ? q1 : q0;
        if (!done && cnt >= 256) T = cand;
        done = done || (cnt == 256);
        if (__all(done)) break;
    }
    unsigned lo_w = 0u, hi_w = 0u;
#pragma unroll
    for (int j = 0; j < 32; ++j) {
        if (2 * j < NKT) {
            const unsigned long long b0 = __ballot(key[2 * j] >= T && key[2 * j] != 0u), b1 = __ballot(key[2 * j + 1] >= T && key[2 * j + 1] != 0u);
            const unsigned a_lo = hi ? (unsigned)(b0 >> 32) : (unsigned)b0, a_hi = hi ? (unsigned)(b1 >> 32) : (unsigned)b1;
            lo_w = (r32 == j) ? a_lo : lo_w; hi_w = (r32 == j) ? a_hi : hi_w;
        }
    }
    *mrow = (unsigned long long)lo_w | ((unsigned long long)hi_w << 32);
}

constexpr int RING_BYTES = 131072, LDSCTL_OFF = RING_BYTES, MISC_OFF = LDSCTL_OFF + 320, LDS_BYTES = 147456;
constexpr int NPHASE = 2 + 11 * DEPTH + 1;
constexpr int CW_BAR = 4096;
static_assert((CW_BAR + NPHASE * XCD_BAR_WORDS) * 4 <= (int)CTL_BYTES, "ctl");

struct Args { const float* in[16]; float* out; unsigned char* ws; int ph_lo, ph_hi, li, pad; };

template <int MAP>
__device__ __forceinline__ int src_col(int n) {
    if (MAP == 0) return n;
    if (MAP == 2) { const int pn = n >> 8, bj = (n >> 7) & 1, cc = n & 127; return bj * DFF + pn * 128 + cc; }
    if (n < 3072) return n;
    if (n < 5120) { const int base = n & ~127, p = n & 127, g = p >> 3, j = p & 7; return base + ((j < 4) ? 4 * g + j : 64 + 4 * g + (j - 4)); }
    if (n < 6144) return n;
    if (n < 7168) { const int base = n & ~63, p = n & 63, g = p >> 3, j = p & 7; return base + ((j < 4) ? 4 * g + j : 32 + 4 * g + (j - 4)); }
    if (n < 9216) return 7248 + (n - 7168);
    if (n < 11264) return 9296 + (n - 9216);
    if (n < 11328) { const int p = n - 11264, g = p >> 3, j = p & 7; return 7168 + ((j < 4) ? 4 * g + j : 32 + 4 * g + (j - 4)); }
    if (n < 11344) return 7232 + (n - 11328);
    return -1;
}
template <int MAP>
__device__ __forceinline__ void convert_item(const GAS float* W, int Nsrc, GAS bf16_t* WT, int ldk, int kdst, int nblk, int item, int lane) {
    const int kb = item / nblk, nb = item % nblk, k0 = 32 * kb, n = 64 * nb + lane;
    const int sc_ = src_col<MAP>(n);
    const GAS float* wp = W + (size_t)k0 * Nsrc + (sc_ >= 0 ? sc_ : 0);
    float v[32];
#pragma unroll
    for (int i = 0; i < 32; ++i) v[i] = __builtin_nontemporal_load(wp + (size_t)i * Nsrc);
    if (sc_ < 0) {
#pragma unroll
        for (int i = 0; i < 32; ++i) v[i] = 0.f;
    }
    GAS u32x4* op = (GAS u32x4*)(WT + (size_t)n * ldk + kdst + k0);
#pragma unroll
    for (int g = 0; g < 4; ++g) { u32x4 o = {cvtpk(v[8 * g], v[8 * g + 1]), cvtpk(v[8 * g + 2], v[8 * g + 3]), cvtpk(v[8 * g + 4], v[8 * g + 5]), cvtpk(v[8 * g + 6], v[8 * g + 7])}; op[g] = o; }
}

typedef const __attribute__((address_space(4))) Args* KArgs;
__device__ __forceinline__ KArgs kargs() { KArgs k = (KArgs)__builtin_amdgcn_kernarg_segment_ptr(); asm volatile("" : "+s"(k)); return k; }
#define KIN(i) ((const GAS float*)kargs()->in[i])
#define WSP(T, off) ((GAS T*)((GAS unsigned char*)kargs()->ws + (off)))

template <bool COPY>
__device__ __forceinline__ void norm_rows(const GAS float* xsrc, const GAS float* gain, const GAS float* modb  ,
                                          GAS bf16_t* hb, GAS float* copy_to, int gw, int NGW, int lane) {
    for (int wv = gw; wv < NBATCH * 128; wv += NGW) {
        const int b = wv >> 7, rb = wv & 127;
        f32x4 gm[8], sh[8];
        { const GAS f32x4* gp = (const GAS f32x4*)gain + lane; const GAS f32x4* shp = (const GAS f32x4*)(modb + (size_t)b * NMOD) + lane; const GAS f32x4* scp = (const GAS f32x4*)(modb + (size_t)b * NMOD + DM) + lane;
#pragma unroll
          for (int j = 0; j < 8; ++j) { gm[j] = gp[64 * j] * (scp[64 * j] + 1.0f); sh[j] = shp[64 * j]; } }
        f32x4 cur[8], nxt[8];
        { const GAS f32x4* xr = (const GAS f32x4*)(xsrc + (size_t)(b * SEQ + rb) * DM) + lane;
#pragma unroll
          for (int j = 0; j < 8; ++j) cur[j] = __builtin_nontemporal_load(xr + 64 * j); }
        for (int k = 0; k < 16; ++k) {
            const int row = b * SEQ + rb + 128 * k;
            if (k + 1 < 16) { const GAS f32x4* xr = (const GAS f32x4*)(xsrc + (size_t)(row + 128) * DM) + lane;
#pragma unroll
                for (int j = 0; j < 8; ++j) nxt[j] = __builtin_nontemporal_load(xr + 64 * j); }
            float ss = 0.f;
#pragma unroll
            for (int j = 0; j < 8; ++j) ss += (cur[j][0] * cur[j][0] + cur[j][1] * cur[j][1]) + (cur[j][2] * cur[j][2] + cur[j][3] * cur[j][3]);
            const float rs = 1.f / sqrtf(wave_sum(ss) * (1.f / DM) + NORM_EPS);
            GAS u32x2* op = (GAS u32x2*)(hb + (size_t)row * DM) + lane;
#pragma unroll
            for (int j = 0; j < 8; ++j) {
                const f32x4 hv = cur[j] * rs * gm[j] + sh[j];
                u32x2 o2; o2.x = cvtpk(hv[0], hv[1]); o2.y = cvtpk(hv[2], hv[3]); op[64 * j] = o2;
                if (COPY) ((GAS f32x4*)(copy_to + (size_t)row * DM) + lane)[64 * j] = cur[j];
            }
#pragma unroll
            for (int j = 0; j < 8; ++j) cur[j] = nxt[j];
        }
    }
}

__global__ void __launch_bounds__(512, 2) fwd(Args args) {
    extern __shared__ __attribute__((aligned(16))) unsigned char lds_raw[];
    LAS unsigned char* lds = (LAS unsigned char*)lds_raw;
    volatile LAS unsigned* MISC = (volatile LAS unsigned*)(lds + MISC_OFF);
    const int G = gridDim.x; const int bx = blockIdx.x;
    const int vcu = (G % 8 == 0) ? (bx % 8) * (G / 8) + bx / 8 : bx;
    const int NGW = G * 8;
#define PHASE_IDS() int tid = threadIdx.x; asm volatile("" : "+v"(tid)); const int lane = tid & 63, wave = __builtin_amdgcn_readfirstlane(tid >> 6); const int gw = vcu * 8 + wave; (void)lane; (void)gw

    { PHASE_IDS(); for (int u = tid; u < (LDS_BYTES - LDSCTL_OFF) / 4; u += 512) ((LAS unsigned*)(lds + LDSCTL_OFF))[u] = 0u; }
    __syncthreads();
    const int lo = args.ph_lo, hi_ph = args.ph_hi;
    XcdBarrier bar; bar.bar = (unsigned*)(args.ws + WS_CTL) + CW_BAR + args.li * XCD_BAR_WORDS; bar.x = 0; bar.st = nullptr;
    if (hi_ph - lo > 1) bar = xcd_barrier_post((unsigned*)(args.ws + WS_CTL) + CW_BAR + args.li * XCD_BAR_WORDS, MISC + 8);
#ifndef AUDIT_MASK
#define AUDIT_MASK 0xFFFF
#endif
#define PH_ON(s) ((AUDIT_MASK >> (s)) & 1)
#define IN(k) (lo <= (k) && (k) < hi_ph)
#define SEAM(k) do { if (IN(k) && IN((k) + 1)) xcd_barrier(bar); } while (0)

    if (PH_ON(0) && IN(0)) {
            PHASE_IDS();
        const GAS float* c_in = KIN(1); const GAS int* positions = (const GAS int*)KIN(2); const GAS float* w_ada = KIN(7);
        GAS float* MODP = WSP(float, WS_ACT);
        LAS float* scl = (LAS float*)lds;
        for (int i0 = tid; i0 < NBATCH * DM; i0 += 512 * 16) {
            float cv_[16];
#pragma unroll
            for (int u = 0; u < 16; ++u) cv_[u] = c_in[i0 + u * 512];
#pragma unroll
            for (int u = 0; u < 16; ++u) { const int i = i0 + u * 512, b = i >> 11, k = i & (DM - 1); const float v = cv_[u]; scl[k * 16 + b] = v * fast_sigmoid(v); }
        }
        __syncthreads();
        for (int item = gw; item < DEPTH * 48 * 8; item += NGW) {
            const int kc = item & 7, rem = item >> 3, nb = rem % 48, l = rem / 48, n = nb * 256 + lane * 4;
            const GAS float* Wp = w_ada + ((size_t)l * DM + kc * 256) * NMOD + n;
            f32x4 acc[16];
#pragma unroll
            for (int b = 0; b < 16; ++b) acc[b] = (f32x4){0.f, 0.f, 0.f, 0.f};
            for (int k0 = 0; k0 < 256; k0 += 4, Wp += (size_t)4 * NMOD) {
                asm volatile("" : "+v"(Wp));
                f32x4 wv_[4];
#pragma unroll
                for (int u = 0; u < 4; ++u) wv_[u] = __builtin_nontemporal_load((const GAS f32x4*)(Wp + (size_t)u * NMOD));
#pragma unroll
                for (int u = 0; u < 4; ++u) {
                    const LAS f32x4* s4 = (const LAS f32x4*)(scl + (kc * 256 + k0 + u) * 16);
                    const f32x4 s0 = s4[0], s1 = s4[1], s2 = s4[2], s3 = s4[3];
#pragma unroll
                    for (int j = 0; j < 4; ++j) { acc[j] += wv_[u] * s0[j]; acc[4 + j] += wv_[u] * s1[j]; acc[8 + j] += wv_[u] * s2[j]; acc[12 + j] += wv_[u] * s3[j]; }
                }
            }
#pragma unroll
            for (int b = 0; b < 16; ++b) *(GAS f32x4*)(MODP + ((size_t)(kc * DEPTH + l) * 16 + b) * NMOD + n) = acc[b];
        }
        GAS float* COS128 = WSP(float, WS_COS128); GAS float* SIN128 = WSP(float, WS_SIN128); GAS float* COS64 = WSP(float, WS_COS64); GAS float* SIN64 = WSP(float, WS_SIN64);
        int pos_nx = positions[(bx * 512 + tid) / 96];
        for (int i = bx * 512 + tid; i < MTOK * 96; i += G * 512) {
            const int tok = i / 96, j = i % 96;
            const int pos_cur = pos_nx; { const int i2 = i + G * 512; if (i2 < MTOK * 96) pos_nx = positions[i2 / 96]; }
            const int e = (j < 64) ? j : 2 * (j - 64);
            double inv = 1.0, p = 0.8659643233600653;
            for (int q = 0; q < 6; ++q) { if ((e >> q) & 1) inv *= p; p *= p; }
            const double ang = (double)pos_cur * inv;
            const double kq = __builtin_rint(ang * 0.6366197723675814);
            double r = __builtin_fma(-kq, 1.5707963267948966, ang); r = __builtin_fma(-kq, 6.123233995736766e-17, r);
            const double r2 = r * r;
            double sn = -1.0 / 1307674368000.0; sn = sn * r2 + 1.0 / 6227020800.0; sn = sn * r2 - 1.0 / 39916800.0; sn = sn * r2 + 1.0 / 362880.0; sn = sn * r2 - 1.0 / 5040.0; sn = sn * r2 + 1.0 / 120.0; sn = sn * r2 - 1.0 / 6.0; sn = sn * r2 * r + r;
            double cs = 1.0 / 20922789888000.0; cs = cs * r2 - 1.0 / 87178291200.0; cs = cs * r2 + 1.0 / 479001600.0; cs = cs * r2 - 1.0 / 3628800.0; cs = cs * r2 + 1.0 / 40320.0; cs = cs * r2 - 1.0 / 720.0; cs = cs * r2 + 1.0 / 24.0; cs = cs * r2 - 0.5; cs = cs * r2 + 1.0;
            const int qd = ((int)(long long)kq) & 3;
            const double cc = (qd == 0) ? cs : (qd == 1) ? -sn : (qd == 2) ? -cs : sn;
            const double ss = (qd == 0) ? sn : (qd == 1) ? cs : (qd == 2) ? -sn : -cs;
            if (j < 64) { COS128[(size_t)tok * 64 + j] = (float)cc; SIN128[(size_t)tok * 64 + j] = (float)ss; }
            else { COS64[(size_t)tok * 32 + (j - 64)] = (float)cc; SIN64[(size_t)tok * 32 + (j - 64)] = (float)ss; }
        }
        __syncthreads();
    }
    SEAM(0);
    if (PH_ON(1) && IN(1)) {
            PHASE_IDS();
        const GAS float* b_ada = KIN(8); const GAS float* MODP = WSP(float, WS_ACT); GAS float* MOD = WSP(float, WS_MOD);
        for (int i = bx * 512 + tid; i < DEPTH * 16 * NMOD; i += G * 512) {
            const int n = i % NMOD, l = i / (16 * NMOD);
            float s = b_ada[(size_t)l * NMOD + n];
#pragma unroll
            for (int kc = 0; kc < 8; ++kc) s += MODP[(size_t)kc * DEPTH * 16 * NMOD + i];
            MOD[i] = s;
        }
    }
    SEAM(1);

    for (int layer = 0; layer < DEPTH; ++layer) {
        const int pb = 2 + 11 * layer;
        if (PH_ON(2) && IN(pb + 0)) {
            PHASE_IDS();
            constexpr int I_IN = 64 * (LDP / 64), I_A = 32 * 32, I_O = 64 * 32, I_UP = 64 * (NUP / 64), I_DN = (DFF / 32) * 32;
            constexpr int I_DN_LATE = 4096;
            constexpr int NITEMS = I_IN + 2 * I_A + I_O + I_UP + I_DN - I_DN_LATE;
            const GAS float* modl = WSP(float, WS_MOD) + (size_t)layer * 16 * NMOD;
            const GAS float* g_mix = KIN(9) + (size_t)layer * DM;
            GAS float* X = (GAS float*)kargs()->out; GAS bf16_t* HB = WSP(bf16_t, WS_HB);
            norm_rows<false>((layer == 0) ? KIN(0) : (const GAS float*)X, g_mix, modl, HB, nullptr, gw, NGW, lane);
            for (int it = gw; it < NITEMS; it += NGW) {
                int r = it;
                if (r < I_IN) { convert_item<1>(KIN(3) + (size_t)layer * DM * IN_W, IN_W, WSP(bf16_t, WS_WIN), DM, 0, LDP / 64, r, lane); continue; } r -= I_IN;
                if (r < I_A) { convert_item<0>(KIN(4) + (size_t)layer * 1024 * DM, DM, WSP(bf16_t, WS_WAB), DM, 0, 32, r, lane); continue; } r -= I_A;
                if (r < I_A) { convert_item<0>(KIN(5) + (size_t)layer * 1024 * DM, DM, WSP(bf16_t, WS_WAB), DM, 1024, 32, r, lane); continue; } r -= I_A;
                if (r < I_O) { convert_item<0>(KIN(6) + (size_t)layer * DM * DM, DM, WSP(bf16_t, WS_WO), DM, 0, 32, r, lane); continue; } r -= I_O;
                if (r < I_UP) { convert_item<2>(KIN(11) + (size_t)layer * DM * NUP, NUP, WSP(bf16_t, WS_WUP), DM, 0, NUP / 64, r, lane); continue; } r -= I_UP;
                convert_item<0>(KIN(14) + (size_t)layer * DFF * DM, DM, WSP(bf16_t, WS_WDN), DFF, 0, 32, r + I_DN_LATE, lane);
            }
            __syncthreads();
        }
        SEAM(pb + 0);
        if (PH_ON(3) && IN(pb + 1)) {
            pg8::Gemm g{WSP(bf16_t, WS_HB), WSP(bf16_t, WS_WIN), MTOK, LDP, DM}; pg8::StaticOrder S; S.init(MTOK, LDP, G, bx);
            EpiInProj E{WSP(bf16_t, WS_PROJ), WSP(float, WS_COS128), WSP(float, WS_SIN128), WSP(float, WS_COS64), WSP(float, WS_SIN64), WSP(bf16_t, WS_ACT)};
            pg8::gemm_phase<EpiInProj, pg8::StaticOrder, true, true>(lds, g, S, E);
            if (bx >= G / 2) { PHASE_IDS(); for (int r = (bx - G / 2) * 8 + wave; r < 4096; r += (G - G / 2) * 8) convert_item<0>(KIN(14) + (size_t)layer * DFF * DM, DM, WSP(bf16_t, WS_WDN), DFF, 0, 32, r, lane); }
        }
        SEAM(pb + 1);
        if (PH_ON(4) && IN(pb + 2)) {
            const GAS bf16_t* PROJ = WSP(bf16_t, WS_PROJ);
            { PHASE_IDS(); GAS unsigned long long* MK = WSP(unsigned long long, WS_MASK);
              for (int idx = gw; idx < MTOK / 2; idx += NGW) { const int b = idx >> 10, tp = ((idx & 1023) + 131 * (idx / NGW)) & 1023;
                  idxsel_pair(PROJ, WSP(bf16_t, WS_ACT), MK, b, 2 * tp, lane, (LAS unsigned*)(lds + wave * 16384)); }
              __syncthreads(); }
            for (int P = bx; P < 512; P += G) {
                const int bh = P >> 2, y = P & 3;
                sb_attn_unit((LAS char*)lds, PROJ, WSP(bf16_t, WS_Y), bh >> 3, bh & 7, y);
                sb_attn_unit((LAS char*)lds, PROJ, WSP(bf16_t, WS_Y), bh >> 3, bh & 7, 7 - y);
            }
        }
        SEAM(pb + 2);
        if (PH_ON(6) && IN(pb + 4)) {
            const GAS bf16_t* PROJ = WSP(bf16_t, WS_PROJ); const GAS unsigned long long* MK = WSP(unsigned long long, WS_MASK);
            for (int P = bx; P < 512; P += G) {
                const int bh = P >> 2, y = P & 3;
                dsa_attn_unit((LAS char*)lds, PROJ, MK, WSP(bf16_t, WS_Y), bh >> 3, bh & 7, y);
                dsa_attn_unit((LAS char*)lds, PROJ, MK, WSP(bf16_t, WS_Y), bh >> 3, bh & 7, 7 - y);
            }
        }
        SEAM(pb + 4);
        if (PH_ON(7) && IN(pb + 5)) {
            pg8::Gemm g{WSP(bf16_t, WS_Y), WSP(bf16_t, WS_WAB), MTOK, DM, DM}; pg8::StaticOrder S; S.init(MTOK, DM, G, bx);
            EpiGate E{WSP(bf16_t, WS_PROJ), WSP(bf16_t, WS_HB)};
            pg8::gemm_phase<EpiGate, pg8::StaticOrder, true, true>(lds, g, S, E);
        }
        SEAM(pb + 5);
        if (PH_ON(8) && IN(pb + 6)) {
            pg8::Gemm g{WSP(bf16_t, WS_HB), WSP(bf16_t, WS_WO), MTOK, DM, DM}; pg8::StaticOrder S; S.init(MTOK, DM, G, bx);
            EpiResid E{(GAS float*)kargs()->out, (layer == 0) ? KIN(0) : (const GAS float*)kargs()->out, WSP(float, WS_MOD) + (size_t)layer * 16 * NMOD + 2 * DM};
            pg8::gemm_phase<EpiResid, pg8::StaticOrder, true, true>(lds, g, S, E);
        }
        SEAM(pb + 6);
        if (PH_ON(9) && IN(pb + 7)) {
            PHASE_IDS();
            const GAS float* modl = WSP(float, WS_MOD) + (size_t)layer * 16 * NMOD;
            const GAS float* g_ffn = KIN(10) + (size_t)layer * DM;
            const GAS float* X = (const GAS float*)kargs()->out; GAS bf16_t* HB = WSP(bf16_t, WS_HB);
            norm_rows<false>(X, g_ffn, modl + 3 * DM, HB, nullptr, gw, NGW, lane);
        }
        SEAM(pb + 7);
        if (PH_ON(10) && IN(pb + 8)) {
            pg8::Gemm g{WSP(bf16_t, WS_HB), WSP(bf16_t, WS_WUP), MTOK, NUP, DM}; pg8::StaticOrder S; S.init(MTOK, NUP, G, bx);
            EpiConv E{WSP(bf16_t, WS_ACT), WSP(float, WS_H0), WSP(float, WS_H1), KIN(12) + (size_t)layer * 3 * NUP, KIN(13) + (size_t)layer * NUP, lds + RING_BYTES + 1024};
            pg8::gemm_phase<EpiConv, pg8::StaticOrder, true, true>(lds, g, S, E);
        }
        SEAM(pb + 8);
        if (PH_ON(11) && IN(pb + 9)) {
            PHASE_IDS();
            const GAS float* cw = KIN(12) + (size_t)layer * 3 * NUP; const GAS float* cb = KIN(13) + (size_t)layer * NUP;
            const GAS float* H0 = WSP(float, WS_H0); const GAS float* H1 = WSP(float, WS_H1); GAS bf16_t* ACT = WSP(bf16_t, WS_ACT);
            for (int item = bx * 512 + tid; item < 128 * 704; item += G * 512) {
                const int pm = item / 704, cg = item % 704, ch = cg * 8, pn = ch >> 7, cc = ch & 127;
                const bool first = (pm & 7) == 0;
                float um2[2][8], um1[2][8], u0[2][8], u1[2][8];
#pragma unroll
                for (int ab = 0; ab < 2; ++ab) {
                    const int col = pn * 256 + ab * 128 + cc;
#pragma unroll
                    for (int h = 0; h < 2; ++h) {
                        const f32x4 a0 = *(const GAS f32x4*)(H0 + ((size_t)pm * 2 + 0) * NUP + col + 4 * h), a1 = *(const GAS f32x4*)(H0 + ((size_t)pm * 2 + 1) * NUP + col + 4 * h);
                        f32x4 p2 = {0.f, 0.f, 0.f, 0.f}, p1 = {0.f, 0.f, 0.f, 0.f};
                        if (!first) { p2 = *(const GAS f32x4*)(H1 + ((size_t)(pm - 1) * 2 + 0) * NUP + col + 4 * h); p1 = *(const GAS f32x4*)(H1 + ((size_t)(pm - 1) * 2 + 1) * NUP + col + 4 * h); }
#pragma unroll
                        for (int j = 0; j < 4; ++j) { um2[ab][4 * h + j] = p2[j]; um1[ab][4 * h + j] = p1[j]; u0[ab][4 * h + j] = a0[j]; u1[ab][4 * h + j] = a1[j]; }
                    }
                }
                float o0[8], o1[8];
#pragma unroll
                for (int j = 0; j < 8; ++j) {
                    const float wa0 = cw[ch + j], wa1 = cw[NUP + ch + j], wa2 = cw[2 * NUP + ch + j], ba = cb[ch + j];
                    const float wb0 = cw[DFF + ch + j], wb1 = cw[NUP + DFF + ch + j], wb2 = cw[2 * NUP + DFF + ch + j], bb = cb[DFF + ch + j];
                    const float av0 = ba + wa0 * um2[0][j] + wa1 * um1[0][j] + wa2 * u0[0][j], bv0 = bb + wb0 * um2[1][j] + wb1 * um1[1][j] + wb2 * u0[1][j];
                    const float av1 = ba + wa0 * um1[0][j] + wa1 * u0[0][j] + wa2 * u1[0][j], bv1 = bb + wb0 * um1[1][j] + wb1 * u0[1][j] + wb2 * u1[1][j];
                    o0[j] = av0 * fast_sigmoid(av0) * bv0; o1[j] = av1 * fast_sigmoid(av1) * bv1;
                }
                u32x4 q0 = {cvtpk(o0[0], o0[1]), cvtpk(o0[2], o0[3]), cvtpk(o0[4], o0[5]), cvtpk(o0[6], o0[7])}, q1 = {cvtpk(o1[0], o1[1]), cvtpk(o1[2], o1[3]), cvtpk(o1[4], o1[5]), cvtpk(o1[6], o1[7])};
                *(GAS u32x4*)(ACT + (size_t)(pm * 256) * DFF + ch) = q0; *(GAS u32x4*)(ACT + (size_t)(pm * 256 + 1) * DFF + ch) = q1;
            }
        }
        SEAM(pb + 9);
        if (PH_ON(12) && IN(pb + 10)) {
            pg8::Gemm g{WSP(bf16_t, WS_ACT), WSP(bf16_t, WS_WDN), MTOK, DM, DFF}; pg8::StaticOrder S; S.init(MTOK, DM, G, bx);
            EpiResid E{(GAS float*)kargs()->out, (const GAS float*)kargs()->out, WSP(float, WS_MOD) + (size_t)layer * 16 * NMOD + 5 * DM};
            pg8::gemm_phase<EpiResid, pg8::StaticOrder, true, true>(lds, g, S, E);
        }
        SEAM(pb + 10);
    }

    if (PH_ON(13) && IN(NPHASE - 1)) {
            PHASE_IDS();
        GAS float* X = (GAS float*)kargs()->out; const GAS float* g_final = KIN(15);
        f32x4 gm[8];
#pragma unroll
        for (int j = 0; j < 8; ++j) gm[j] = ((const GAS f32x4*)g_final + lane)[64 * j];
        for (int wv = gw; wv < NBATCH * 128; wv += NGW) {
            const int b = wv >> 7, rb = wv & 127;
            f32x4 cur[8], nxt[8];
#pragma unroll
            for (int j = 0; j < 8; ++j) cur[j] = ((const GAS f32x4*)(X + (size_t)(b * SEQ + rb) * DM) + lane)[64 * j];
            for (int k = 0; k < 16; ++k) {
                const int row = b * SEQ + rb + 128 * k;
                if (k + 1 < 16) {
#pragma unroll
                    for (int j = 0; j < 8; ++j) nxt[j] = ((const GAS f32x4*)(X + (size_t)(row + 128) * DM) + lane)[64 * j]; }
                float ss = 0.f;
#pragma unroll
                for (int j = 0; j < 8; ++j) ss += (cur[j][0] * cur[j][0] + cur[j][1] * cur[j][1]) + (cur[j][2] * cur[j][2] + cur[j][3] * cur[j][3]);
                const float rs = 1.f / sqrtf(wave_sum(ss) * (1.f / DM) + NORM_EPS);
#pragma unroll
                for (int j = 0; j < 8; ++j) ((GAS f32x4*)(X + (size_t)row * DM) + lane)[64 * j] = cur[j] * rs * gm[j];
#pragma unroll
                for (int j = 0; j < 8; ++j) cur[j] = nxt[j];
            }
        }
    }
#undef IN
#undef SEAM
}

extern "C" void kernel_launch(void* const* d_in, const int* in_sizes, int n_in, void* d_out, int out_size, void* d_ws, size_t ws_size, hipStream_t stream) {
    static int grid = 0;
    if (grid == 0) {
        if (n_in != 16 || out_size != MTOK * DM || ws_size < WS_END) { fprintf(stderr, "kernel_launch: unexpected shapes (n_in %d out %d ws %zu)\n", n_in, out_size, ws_size); grid = -1; return; }
        int dev = 0, cus = 0, per_cu = 0;
        if (hipGetDevice(&dev) != hipSuccess || hipDeviceGetAttribute(&cus, hipDeviceAttributeMultiprocessorCount, dev) != hipSuccess) { grid = -1; return; }
        if (hipFuncSetAttribute((const void*)fwd, hipFuncAttributeMaxDynamicSharedMemorySize, LDS_BYTES) != hipSuccess) { fprintf(stderr, "kernel_launch: hipFuncSetAttribute failed\n"); grid = -1; return; }
        if (hipOccupancyMaxActiveBlocksPerMultiprocessor(&per_cu, (const void*)fwd, 512, LDS_BYTES) != hipSuccess || per_cu < 1) { fprintf(stderr, "kernel_launch: occupancy query says %d\n", per_cu); }
        (void)hipGetLastError();
        grid = cus;
    }
    if (grid < 0) return;
    (void)hipMemsetAsync((char*)d_ws + WS_CTL, 0, CTL_BYTES, stream);
    Args a{};
    for (int i = 0; i < 16; ++i) a.in[i] = (const float*)d_in[i];
    a.out = (float*)d_out; a.ws = (unsigned char*)d_ws;
#if MK_ONE_LAUNCH
    a.ph_lo = 0; a.ph_hi = NPHASE; a.li = 0;
    hipLaunchKernelGGL(fwd, dim3(grid), dim3(512), LDS_BYTES, stream, a);
#else
    for (int p = 0; p < NPHASE; ++p) { a.ph_lo = p; a.ph_hi = p + 1; a.li = p; hipLaunchKernelGGL(fwd, dim3(grid), dim3(512), LDS_BYTES, stream, a); }
#endif
}
```

```cpp
#include <hip/hip_runtime.h>
#include <cstdio>
#include <cstdint>

#ifndef MK_ONE_LAUNCH
#define MK_ONE_LAUNCH 1
#endif

#define LAS __attribute__((address_space(3)))
#define GAS __attribute__((address_space(1)))
typedef unsigned short bf16_t;
typedef short bf16x8 __attribute__((ext_vector_type(8)));
typedef short s16x4 __attribute__((ext_vector_type(4)));
typedef float f32x4 __attribute__((ext_vector_type(4)));
typedef float f32x16 __attribute__((ext_vector_type(16)));
typedef unsigned u32x4 __attribute__((ext_vector_type(4)));
typedef unsigned u32x2 __attribute__((ext_vector_type(2)));

constexpr int DM = 2048, NBATCH = 16, SEQ = 2048, DEPTH = 4, MTOK = NBATCH * SEQ;
constexpr int DFF = 5632, NUP = 2 * DFF, NMOD = 6 * DM;
constexpr int IN_W = 11344;
constexpr int LDP = 11520;
constexpr int C_QSB = 0, C_KSB = 1024, C_VSB = 2048, C_QD = 3072, C_KD = 4096, C_VD = 5120, C_QI = 6144, C_SA = 7168, C_SB = 9216, C_KI = 11264, C_WI = 11328;
constexpr float NORM_EPS = 1e-6f;

constexpr size_t MiB = 1u << 20;
constexpr size_t WS_CTL = 0, CTL_BYTES = 1 * MiB;
constexpr size_t WS_MOD = 1 * MiB;
constexpr size_t WS_COS128 = 4 * MiB, WS_SIN128 = 12 * MiB;
constexpr size_t WS_COS64 = 20 * MiB, WS_SIN64 = 24 * MiB;
constexpr size_t WS_MASK = 28 * MiB;
constexpr size_t WS_WIN = 36 * MiB;
constexpr size_t WS_WAB = 81 * MiB;
constexpr size_t WS_WO = 89 * MiB;
constexpr size_t WS_WUP = 97 * MiB;
constexpr size_t WS_WDN = 141 * MiB;
constexpr size_t WS_HB = 163 * MiB;
constexpr size_t WS_Y = 291 * MiB;
constexpr size_t WS_PROJ = 419 * MiB;
constexpr size_t WS_ACT = 1139 * MiB;
constexpr size_t WS_H0 = 1491 * MiB;
constexpr size_t WS_H1 = 1503 * MiB;
constexpr size_t WS_END = 1515 * MiB;

namespace pg8 {
constexpr int BM = 256, BK = 64, HALF = 128, HTB = HALF * BK * 2, STAGE_BYTES = 8 * HTB, NXCD = 8, WGM = 4;
__host__ __device__ __forceinline__ int lds_byte(int r, int c) { const int st = (r >> 4) * 2 + (c >> 5), rr = r & 15, cc = c & 31, ob = rr * 64 + cc * 2; return st * 1024 + (ob ^ (((ob >> 9) & 1) << 5)); }
__host__ __device__ __forceinline__ void stage_rc(int b, int& R, int& C) { const int st = b / 1024, sb = b % 1024, swz = sb ^ (((sb >> 9) & 1) << 5); R = (st >> 1) * 16 + swz / 64; C = (st & 1) * 32 + (swz % 64) / 2; }
__host__ __device__ __forceinline__ int perm32(int rho) { const int n = rho >> 4, i = rho & 15; return 8 * (i >> 2) + 4 * n + (i & 3); }
struct Unit { int pm, pn; };
struct Gemm { const GAS bf16_t* A; const GAS bf16_t* Bt; int M, N, K; };
struct StaticOrder {
    int nM, nN, nwg, G, c;
    __host__ __device__ void init(int M, int N, int G_, int c_) { nM = M / BM; nN = N / BM; nwg = nM * nN; G = G_; c = c_; }
    __host__ __device__ bool next(int i, Unit& u) const {
        const long L = (long)i * G + c; if (L >= nwg) return false;
        int wgid = (int)L; { const int q = nwg / NXCD, r = nwg % NXCD, xcd = wgid % NXCD, off = wgid / NXCD; wgid = (xcd < r ? xcd * (q + 1) : r * (q + 1) + (xcd - r) * q) + off; }
        const int nig = WGM * nN, gid = wgid / nig, fm = gid * WGM, gsz = (nM - fm) < WGM ? (nM - fm) : WGM;
        u.pm = fm + ((wgid % nig) % gsz); u.pn = (wgid % nig) / gsz; return true;
    }
    __device__ __forceinline__ void a_ready(const Unit&) const {}
    __device__ __forceinline__ void done(const Unit&) const {}
};

template <class Epi, class Sched, bool ALIGN_EPI = false, bool SP2 = false>
__device__ __forceinline__ void gemm_phase(LAS unsigned char* lds, const Gemm g, const Sched& S, const Epi& E) {
    int tid = threadIdx.x; asm volatile("" : "+v"(tid));
    const int wid = __builtin_amdgcn_readfirstlane(tid >> 6), lane = tid & 63, wr = wid >> 2, wc = wid & 3, fr = lane & 15, fq = lane >> 4;
    const int K = g.K, nt = K / BK;
    unsigned voffA[2], voffB[2];
#pragma unroll
    for (int i = 0; i < 2; ++i) { int R, C; stage_rc(tid * 16 + i * 8192, R, C); const int Rb = Epi::PERM ? ((R & ~31) + perm32(R & 31)) : R;
        voffA[i] = (unsigned)(R * K + C) * 2u; voffB[i] = (unsigned)(Rb * K + C) * 2u; }
    const size_t kstep = (size_t)(BK * 2);
    const size_t hstep = (size_t)HALF * K * 2;
    const size_t tstep = 2 * hstep;
    const unsigned ldsw = (unsigned)wid * 1024u;
    const int aoff = lds_byte(wr * 64 + fr, fq * 8), boff = lds_byte(wc * 32 + fr, fq * 8);
#define PG8_SA(b, h) (((b) * 2 + (h)) * HTB)
#define PG8_SB(b, h) ((4 + (b) * 2 + (h)) * HTB)
#define PG8_STAGE(bufoff, gbase, voff) do { _Pragma("unroll") for (int _i = 0; _i < 2; ++_i) \
        __builtin_amdgcn_global_load_lds((const GAS unsigned*)((const GAS char*)(gbase) + (voff)[_i]), (LAS unsigned*)(lds + (bufoff) + ldsw + _i * 8192), 16, 0, 0); } while (0)
#define PG8_LDA(dst, b, h) do { _Pragma("unroll") for (int m = 0; m < 4; ++m) _Pragma("unroll") for (int k = 0; k < 2; ++k) dst[m][k] = *(const LAS bf16x8*)(lds + PG8_SA(b, h) + aoff + m * 2048 + k * 1024); } while (0)
#define PG8_LDB(dst, b, h) do { _Pragma("unroll") for (int n = 0; n < 2; ++n) _Pragma("unroll") for (int k = 0; k < 2; ++k) dst[n][k] = *(const LAS bf16x8*)(lds + PG8_SB(b, h) + boff + n * 2048 + k * 1024); } while (0)
#define PG8_MMA(ai, bj, At, Bt) do { __builtin_amdgcn_s_setprio(1); _Pragma("unroll") for (int m = 0; m < 4; ++m) _Pragma("unroll") for (int n = 0; n < 2; ++n) _Pragma("unroll") for (int k = 0; k < 2; ++k) \
        acc[ai][bj][m][n] = __builtin_amdgcn_mfma_f32_16x16x32_bf16(Bt[n][k], At[m][k], acc[ai][bj][m][n], 0, 0, 0); __builtin_amdgcn_s_setprio(0); } while (0)
#define PG8_WAIT_V(n) asm volatile("s_waitcnt vmcnt(" #n ")" ::: "memory")
#define PG8_WAIT_L(n) asm volatile("s_waitcnt lgkmcnt(" #n ")" ::: "memory")
#define PG8_BAR __builtin_amdgcn_s_barrier()
#define PG8_SCHED __builtin_amdgcn_sched_barrier(0)
    Unit cur, nxt; int ui = 0;
    if (!S.next(0, cur)) return;
    f32x4 acc[2][2][4][2];
#pragma unroll
    for (int a = 0; a < 2; ++a)
#pragma unroll
        for (int b = 0; b < 2; ++b)
#pragma unroll
            for (int m = 0; m < 4; ++m)
#pragma unroll
                for (int n = 0; n < 2; ++n) acc[a][b][m][n] = (f32x4){0.f, 0.f, 0.f, 0.f};
    bf16x8 At[4][2], B0[2][2], B1[2][2];
    const GAS char* cA = (const GAS char*)g.A + (size_t)cur.pm * tstep; const GAS char* cB = (const GAS char*)g.Bt + (size_t)cur.pn * tstep;
    S.a_ready(cur);
    if constexpr (SP2) {
        PG8_STAGE(PG8_SB(0, 0), cB, voffB); PG8_STAGE(PG8_SB(0, 1), cB + hstep, voffB); PG8_STAGE(PG8_SA(0, 0), cA, voffA); PG8_STAGE(PG8_SA(0, 1), cA + hstep, voffA);
        if (wr == 1) PG8_BAR;
        PG8_WAIT_V(2); PG8_BAR;
        PG8_STAGE(PG8_SB(1, 0), cB + kstep, voffB); PG8_STAGE(PG8_SA(1, 0), cA + kstep, voffA); PG8_STAGE(PG8_SB(1, 1), cB + hstep + kstep, voffB);
        PG8_WAIT_V(6); PG8_BAR;
    } else {
        PG8_STAGE(PG8_SB(0, 0), cB, voffB); PG8_STAGE(PG8_SA(0, 0), cA, voffA); PG8_STAGE(PG8_SB(0, 1), cB + hstep, voffB); PG8_STAGE(PG8_SA(0, 1), cA + hstep, voffA);
        if (wr == 1) PG8_BAR;
        PG8_WAIT_V(4); PG8_BAR;
        PG8_STAGE(PG8_SB(1, 0), cB + kstep, voffB); PG8_STAGE(PG8_SA(1, 0), cA + kstep, voffA); PG8_STAGE(PG8_SB(1, 1), cB + hstep + kstep, voffB);
        PG8_WAIT_V(6); PG8_BAR;
    }
    for (;;) {
        const bool has_next = S.next(ui + 1, nxt);
        const GAS char* nA = has_next ? (const GAS char*)g.A + (size_t)nxt.pm * tstep : cA; const GAS char* nB = has_next ? (const GAS char*)g.Bt + (size_t)nxt.pn * tstep : cB;
        for (int t = 0; t < nt; t += 2) {
            const bool last = (t == nt - 2);
            const GAS char* a1 = cA + (size_t)(t + 1) * kstep;
            const GAS char* a2 = last ? nA : cA + (size_t)(t + 2) * kstep; const GAS char* b2 = last ? nB : cB + (size_t)(t + 2) * kstep;
            const GAS char* a3 = a2 + kstep; const GAS char* b3 = b2 + kstep;
            if (last && has_next) S.a_ready(nxt);
            if constexpr (Epi::HAS_MID) { if (t == (nt >> 1)) E.mid(acc, cur, wr, wc, fr, fq); }
            if constexpr (SP2) {
            PG8_LDB(B0, 0, 0); PG8_LDB(B1, 0, 1); PG8_SCHED; PG8_LDA(At, 0, 0); PG8_STAGE(PG8_SA(1, 1), a1 + hstep, voffA);
            PG8_WAIT_V(8); PG8_WAIT_L(0); PG8_BAR; PG8_MMA(0, 0, At, B0); PG8_MMA(0, 1, At, B1); PG8_BAR; PG8_SCHED;
            PG8_LDA(At, 0, 1); PG8_STAGE(PG8_SB(0, 0), b2, voffB); PG8_STAGE(PG8_SB(0, 1), b2 + hstep, voffB); PG8_STAGE(PG8_SA(0, 0), a2, voffA);
            PG8_WAIT_V(8); PG8_WAIT_L(0); PG8_BAR; PG8_MMA(1, 0, At, B0); PG8_MMA(1, 1, At, B1); PG8_BAR; PG8_SCHED;
            PG8_LDB(B0, 1, 0); PG8_LDB(B1, 1, 1); PG8_SCHED; PG8_LDA(At, 1, 0); PG8_STAGE(PG8_SA(0, 1), a2 + hstep, voffA);
            PG8_WAIT_V(8); PG8_WAIT_L(0); PG8_BAR; PG8_MMA(0, 0, At, B0); PG8_MMA(0, 1, At, B1); PG8_BAR; PG8_SCHED;
            PG8_LDA(At, 1, 1); PG8_STAGE(PG8_SB(1, 0), b3, voffB); PG8_STAGE(PG8_SB(1, 1), b3 + hstep, voffB); PG8_STAGE(PG8_SA(1, 0), a3, voffA);
            PG8_WAIT_V(8); PG8_WAIT_L(0); PG8_BAR; PG8_MMA(1, 0, At, B0); PG8_MMA(1, 1, At, B1); PG8_BAR; PG8_SCHED;
            } else {
            PG8_LDB(B0, 0, 0); PG8_SCHED; PG8_LDA(At, 0, 0); PG8_STAGE(PG8_SA(1, 1), a1 + hstep, voffA);
            PG8_WAIT_L(8); PG8_BAR; PG8_WAIT_L(0); PG8_MMA(0, 0, At, B0); PG8_BAR; PG8_SCHED;
            PG8_LDB(B1, 0, 1); PG8_STAGE(PG8_SB(0, 0), b2, voffB);
            PG8_BAR; PG8_WAIT_L(0); PG8_MMA(0, 1, At, B1); PG8_BAR;
            PG8_LDA(At, 0, 1); PG8_STAGE(PG8_SA(0, 0), a2, voffA);
            PG8_BAR; PG8_WAIT_L(0); PG8_MMA(1, 0, At, B0); PG8_BAR; PG8_SCHED;
            PG8_STAGE(PG8_SB(0, 1), b2 + hstep, voffB);
            PG8_WAIT_V(6); PG8_BAR; PG8_MMA(1, 1, At, B1); PG8_BAR;
            PG8_LDB(B0, 1, 0); PG8_SCHED; PG8_LDA(At, 1, 0); PG8_STAGE(PG8_SA(0, 1), a2 + hstep, voffA);
            PG8_WAIT_L(8); PG8_BAR; PG8_WAIT_L(0); PG8_MMA(0, 0, At, B0); PG8_BAR; PG8_SCHED;
            PG8_LDB(B1, 1, 1); PG8_STAGE(PG8_SB(1, 0), b3, voffB);
            PG8_BAR; PG8_WAIT_L(0); PG8_MMA(0, 1, At, B1); PG8_BAR;
            PG8_LDA(At, 1, 1); PG8_STAGE(PG8_SA(1, 0), a3, voffA);
            PG8_BAR; PG8_WAIT_L(0); PG8_MMA(1, 0, At, B0); PG8_BAR; PG8_SCHED;
            PG8_STAGE(PG8_SB(1, 1), b3 + hstep, voffB);
            PG8_WAIT_V(6); PG8_BAR; PG8_MMA(1, 1, At, B1); PG8_BAR;
            }
        }
        if constexpr (ALIGN_EPI) { if (wr == 0) PG8_BAR; }
        E(acc, cur, wr, wc, fr, fq); S.done(cur);
        if (!has_next) break;
#pragma unroll
        for (int a = 0; a < 2; ++a)
#pragma unroll
            for (int b = 0; b < 2; ++b)
#pragma unroll
                for (int m = 0; m < 4; ++m)
#pragma unroll
                    for (int n = 0; n < 2; ++n) acc[a][b][m][n] = (f32x4){0.f, 0.f, 0.f, 0.f};
        cur = nxt; cA = nA; cB = nB; ++ui;
        if constexpr (ALIGN_EPI) { if (wr == 1) PG8_BAR; }
    }
    PG8_WAIT_V(0);
    if constexpr (!ALIGN_EPI) { if (wr == 0) PG8_BAR; }
    PG8_BAR;
#undef PG8_SA
#undef PG8_SB
#undef PG8_STAGE
#undef PG8_LDA
#undef PG8_LDB
#undef PG8_MMA
#undef PG8_WAIT_V
#undef PG8_WAIT_L
#undef PG8_BAR
#undef PG8_SCHED
}
}

#define LDS_WAIT() asm volatile("s_waitcnt lgkmcnt(0)" ::: "memory")
#define VM_WAIT() asm volatile("s_waitcnt vmcnt(0)" ::: "memory")
#define SBAR() __builtin_amdgcn_sched_barrier(0)
typedef float f32x2 __attribute__((ext_vector_type(2)));
typedef __bf16 bf16x2_t __attribute__((ext_vector_type(2)));
__device__ __forceinline__ unsigned cvtpk(float lo, float hi) { const f32x2 v = {lo, hi}; return __builtin_bit_cast(unsigned, __builtin_convertvector(v, bf16x2_t)); }
__device__ __forceinline__ float bf_lo(unsigned w) { return __uint_as_float(w << 16); }
__device__ __forceinline__ float bf_hi(unsigned w) { return __uint_as_float(w & 0xffff0000u); }
__device__ __forceinline__ u32x4 pack8f(f32x4 a, f32x4 b) { u32x4 w = {cvtpk(a[0], a[1]), cvtpk(a[2], a[3]), cvtpk(b[0], b[1]), cvtpk(b[2], b[3])}; return w; }
__device__ __forceinline__ float wave_sum(float v) {
#pragma unroll
    for (int o = 1; o < 64; o <<= 1) v += __shfl_xor(v, o);
    return v;
}
__device__ __forceinline__ float fast_sigmoid(float v) { return __builtin_amdgcn_rcpf(1.f + __builtin_amdgcn_exp2f(-1.4426950408889634f * v)); }

#define XB_TMO      128
#define XB_XCNT(j)  (256  + 64 * (j))
#define XB_XSUB(j)  (1280 + 64 * (j))
#define XB_XGEN(j)  (2304 + 64 * (j))
#define XB_TOP      3328
#define XB_TOPGEN   3392
#define XCD_BAR_WORDS 3456
#define XB_SPIN_CAP (1u << 22)
__device__ __forceinline__ unsigned xb_ld(unsigned* p)              { return __hip_atomic_load(p, __ATOMIC_RELAXED, __HIP_MEMORY_SCOPE_AGENT); }
__device__ __forceinline__ unsigned xb_add(unsigned* p, unsigned v) { return __hip_atomic_fetch_add(p, v, __ATOMIC_RELAXED, __HIP_MEMORY_SCOPE_AGENT); }
__device__ __forceinline__ unsigned xb_xcc_id() { return (unsigned)__builtin_amdgcn_s_getreg((3 << 11) | 20) & 0xFu; }
#define XB_SPIN(cond, bar) do { unsigned _sp = 0; while (cond) { __builtin_amdgcn_s_sleep(1); \
    if ((++_sp & 255u) == 0u) { if (xb_ld(&(bar)[XB_TMO])) break; if (_sp > XB_SPIN_CAP) { atomicAdd(&(bar)[XB_TMO], 1u); break; } } } } while (0)
struct XcdBarrier { unsigned* bar; unsigned x; volatile LAS unsigned* st; };
__device__ __forceinline__ XcdBarrier xcd_barrier_post(unsigned* bar, volatile LAS unsigned* st) {
    XcdBarrier b; b.bar = bar; b.x = xb_xcc_id(); b.st = st;
    if (threadIdx.x == 0) (void)xb_add(&bar[XB_XCNT(b.x)], 1u);
    return b;
}
__device__ __forceinline__ void xcd_barrier_complete(unsigned* bar, unsigned x, unsigned& nloc, unsigned& nx) {
    const unsigned G = gridDim.x * gridDim.y * gridDim.z;
    unsigned sum, cnt, mine, sp = 0u;
    for (;;) {
        sum = 0u; cnt = 0u; mine = 0u;
#pragma unroll
        for (unsigned j = 0; j < 16; ++j) { const unsigned c = xb_ld(&bar[XB_XCNT(j)]); sum += c; cnt += (c > 0u) ? 1u : 0u; mine = (j == x) ? c : mine; }
        if (sum == G) break;
        __builtin_amdgcn_s_sleep(1);
        if ((++sp & 255u) == 0u) { if (xb_ld(&bar[XB_TMO])) break; if (sp > XB_SPIN_CAP) { atomicAdd(&bar[XB_TMO], 1u); break; } }
    }
    nloc = mine > 0u ? mine : 1u; nx = cnt > 0u ? cnt : 1u;
}
__device__ __forceinline__ void xcd_barrier(const XcdBarrier& b) {
    asm volatile("s_waitcnt vmcnt(0)" ::: "memory");
    __syncthreads();
    if (threadIdx.x == 0) {
        unsigned* bar = b.bar;
        __builtin_amdgcn_s_waitcnt(0);
        unsigned nloc = b.st[0], nx = b.st[1];
        if (nloc == 0u) { xcd_barrier_complete(bar, b.x, nloc, nx); b.st[0] = nloc; b.st[1] = nx; }
        const unsigned old = xb_add(&bar[XB_XSUB(b.x)], 1u);
        const unsigned gen = old / nloc;
        if (old + 1u == (gen + 1u) * nloc) {
            __builtin_amdgcn_fence(__ATOMIC_RELEASE, "agent");
            asm volatile("s_waitcnt vmcnt(0)" ::: "memory");
            const unsigned og = xb_add(&bar[XB_TOP], 1u);
            const unsigned tg = og / nx;
            if (og + 1u == (tg + 1u) * nx) xb_add(&bar[XB_TOPGEN], 1u);
            else XB_SPIN(xb_ld(&bar[XB_TOPGEN]) == tg, bar);
            __builtin_amdgcn_fence(__ATOMIC_ACQUIRE, "agent");
            xb_add(&bar[XB_XGEN(b.x)], 1u);
            asm volatile("s_waitcnt vmcnt(0)" ::: "memory");
        } else {
            XB_SPIN(xb_ld(&bar[XB_XGEN(b.x)]) == gen, bar);
            __builtin_amdgcn_fence(__ATOMIC_ACQUIRE, "agent");
            asm volatile("s_waitcnt vmcnt(0)" ::: "memory");
        }
    }
    __syncthreads();
}

using pg8::Unit;
struct EpiInProj {
    static constexpr bool PERM = true, HAS_MID = false;
    GAS bf16_t* O; const GAS float* cos128; const GAS float* sin128; const GAS float* cos64; const GAS float* sin64; GAS bf16_t* kix;
    template <int KIND>
    __device__ __forceinline__ void tile(const f32x4 (&acc)[2][2][4][2], const Unit& u, int wr, int wc, int fr, int fq) const {
        asm volatile("" : "+v"(fr), "+v"(fq));
        const int row0 = u.pm * 256 + wr * 64 + fr, col0 = u.pn * 256 + wc * 32 + 8 * fq;
#pragma unroll
        for (int ai = 0; ai < 2; ++ai) {
            f32x4 csv[4], snv[4];
#pragma unroll
            for (int m = 0; m < 4; ++m) { const int row = row0 + ai * 128 + m * 16;
                csv[m] = (f32x4){1.f, 1.f, 1.f, 1.f}; snv[m] = (f32x4){0.f, 0.f, 0.f, 0.f};
                if (KIND == 1) { csv[m] = *(const GAS f32x4*)(cos128 + (size_t)row * 64 + 16 * wc + 4 * fq); snv[m] = *(const GAS f32x4*)(sin128 + (size_t)row * 64 + 16 * wc + 4 * fq); }
                if (KIND == 2 || KIND == 4) { csv[m] = *(const GAS f32x4*)(cos64 + (size_t)row * 32 + 16 * (wc & 1) + 4 * fq); snv[m] = *(const GAS f32x4*)(sin64 + (size_t)row * 32 + 16 * (wc & 1) + 4 * fq); } }
#pragma unroll
            for (int m = 0; m < 4; ++m) {
                const int row = row0 + ai * 128 + m * 16;
                GAS bf16_t* rowp = O + (size_t)row * LDP + col0;
                const f32x4 cs = csv[m], sn = snv[m];
#pragma unroll
                for (int bj = 0; bj < 2; ++bj) {
                    f32x4 v0 = acc[ai][bj][m][0], v1 = acc[ai][bj][m][1];
                    bool rope = (KIND == 1 || KIND == 2);
                    if (KIND == 4) rope = (bj == 0 && wc < 2);
                    if (rope) { const f32x4 a = v0 * cs - v1 * sn, b = v1 * cs + v0 * sn; v0 = a; v1 = b; }
                    if (KIND == 3) {
#pragma unroll
                        for (int j = 0; j < 4; ++j) { v0[j] = fast_sigmoid(v0[j]); v1[j] = fast_sigmoid(v1[j]); }
                    }
                    *(GAS u32x4*)(rowp + bj * 128) = pack8f(v0, v1);
                    if (KIND == 4 && bj == 0 && wc < 2) {
                        const int g_ = 4 * wc + fq; *(GAS u32x4*)(kix + ((size_t)(row >> 5) * 4 + (g_ >> 1)) * 512 + (size_t)((row & 31) + 32 * (g_ & 1)) * 8) = pack8f(v0, v1); }
                }
            }
            asm volatile("" ::: "memory");
        }
    }
    __device__ __forceinline__ void operator()(const f32x4 (&acc)[2][2][4][2], const Unit& u, int wr, int wc, int fr, int fq) const {
        const int pn = u.pn;
        if (pn < 12 || (pn >= 20 && pn < 24)) tile<0>(acc, u, wr, wc, fr, fq);
        else if (pn < 20) tile<1>(acc, u, wr, wc, fr, fq);
        else if (pn < 28) tile<2>(acc, u, wr, wc, fr, fq);
        else if (pn < 44) tile<3>(acc, u, wr, wc, fr, fq);
        else tile<4>(acc, u, wr, wc, fr, fq);
    }
    __device__ __forceinline__ void mid(f32x4 (&)[2][2][4][2], const Unit&, int, int, int, int) const {}
};
struct EpiGate {
    static constexpr bool PERM = true, HAS_MID = true;
    const GAS bf16_t* P; GAS bf16_t* O;
    __device__ __forceinline__ void mid(f32x4 (&acc)[2][2][4][2], const Unit& u, int wr, int wc, int fr, int fq) const {
        asm volatile("" : "+v"(fr), "+v"(fq));
        const int row0 = u.pm * 256 + wr * 64 + fr, col0 = u.pn * 256 + wc * 32 + 8 * fq;
#pragma unroll
        for (int ai = 0; ai < 2; ++ai)
#pragma unroll
            for (int mp = 0; mp < 2; ++mp) {
                u32x4 sa[2][2], sb[2][2];
#pragma unroll
                for (int m2 = 0; m2 < 2; ++m2) { const GAS bf16_t* rowp = P + (size_t)(row0 + ai * 128 + (2 * mp + m2) * 16) * LDP + col0;
#pragma unroll
                    for (int bj = 0; bj < 2; ++bj) { sa[m2][bj] = *(const GAS u32x4*)(rowp + C_SA + bj * 128); sb[m2][bj] = *(const GAS u32x4*)(rowp + C_SB + bj * 128); } }
#pragma unroll
                for (int m2 = 0; m2 < 2; ++m2)
#pragma unroll
                    for (int bj = 0; bj < 2; ++bj)
#pragma unroll
                        for (int q = 0; q < 4; ++q) {
                            const float r0 = bf_lo(sa[m2][bj][q]) * __builtin_amdgcn_rcpf(fmaxf(bf_lo(sb[m2][bj][q]), 1e-30f));
                            const float r1 = bf_hi(sa[m2][bj][q]) * __builtin_amdgcn_rcpf(fmaxf(bf_hi(sb[m2][bj][q]), 1e-30f));
                            acc[ai][bj][2 * mp + m2][q >> 1][(q & 1) * 2 + 0] *= r0; acc[ai][bj][2 * mp + m2][q >> 1][(q & 1) * 2 + 1] *= r1;
                        }
                asm volatile("" ::: "memory");
            }
    }
    __device__ __forceinline__ void operator()(const f32x4 (&acc)[2][2][4][2], const Unit& u, int wr, int wc, int fr, int fq) const {
        asm volatile("" : "+v"(fr), "+v"(fq));
        const int row0 = u.pm * 256 + wr * 64 + fr, col0 = u.pn * 256 + wc * 32 + 8 * fq;
#pragma unroll
        for (int ai = 0; ai < 2; ++ai)
#pragma unroll
            for (int mp = 0; mp < 2; ++mp) {
                u32x4 sb[2][2];
#pragma unroll
                for (int m2 = 0; m2 < 2; ++m2)
#pragma unroll
                    for (int bj = 0; bj < 2; ++bj) sb[m2][bj] = *(const GAS u32x4*)(P + (size_t)(row0 + ai * 128 + (2 * mp + m2) * 16) * LDP + col0 + C_SB + bj * 128);
#pragma unroll
                for (int m2 = 0; m2 < 2; ++m2)
#pragma unroll
                    for (int bj = 0; bj < 2; ++bj) {
                        const int row = row0 + ai * 128 + (2 * mp + m2) * 16; const u32x4 w = sb[m2][bj];
                        f32x4 v0 = acc[ai][bj][2 * mp + m2][0], v1 = acc[ai][bj][2 * mp + m2][1];
                        v0[0] *= fmaxf(bf_lo(w[0]), 1e-30f); v0[1] *= fmaxf(bf_hi(w[0]), 1e-30f); v0[2] *= fmaxf(bf_lo(w[1]), 1e-30f); v0[3] *= fmaxf(bf_hi(w[1]), 1e-30f);
                        v1[0] *= fmaxf(bf_lo(w[2]), 1e-30f); v1[1] *= fmaxf(bf_hi(w[2]), 1e-30f); v1[2] *= fmaxf(bf_lo(w[3]), 1e-30f); v1[3] *= fmaxf(bf_hi(w[3]), 1e-30f);
                        *(GAS u32x4*)(O + (size_t)row * DM + col0 + bj * 128) = pack8f(v0, v1);
                    }
                asm volatile("" ::: "memory");
            }
    }
};
__device__ __forceinline__ float dpp_ror8f(float v) { return __builtin_bit_cast(float, __builtin_amdgcn_update_dpp(0, __builtin_bit_cast(int, v), 0x128, 0xf, 0xf, false)); }
__device__ __forceinline__ f32x4 dpp_ror8v(f32x4 v) { f32x4 r; r.x = dpp_ror8f(v.x); r.y = dpp_ror8f(v.y); r.z = dpp_ror8f(v.z); r.w = dpp_ror8f(v.w); return r; }
struct EpiResid {
    static constexpr bool PERM = false, HAS_MID = false;
    GAS float* X; const GAS float* Xin; const GAS float* gate;
    __device__ __forceinline__ void operator()(const f32x4 (&acc)[2][2][4][2], const Unit& u, int wr, int wc, int fr, int fq) const {
        asm volatile("" : "+v"(fr), "+v"(fq));
        const bool lo = fr < 8;
        const int col0 = u.pn * 256 + wc * 32 + 4 * fq;
        const int rowA = u.pm * 256 + wr * 64 + (fr & 7), colA = col0 + (lo ? 0 : 16);
        const GAS float* gp = gate + (size_t)(u.pm >> 3) * NMOD + col0;
        f32x4 gv[2][2];
#pragma unroll
        for (int bj = 0; bj < 2; ++bj)
#pragma unroll
            for (int n = 0; n < 2; ++n) gv[bj][n] = *(const GAS f32x4*)(gp + bj * 128 + n * 16);
        asm volatile("" : "+v"(gv[0][0]), "+v"(gv[0][1]), "+v"(gv[1][0]), "+v"(gv[1][1]));
#pragma unroll
        for (int bj = 0; bj < 2; ++bj)
#pragma unroll
            for (int n = 0; n < 2; ++n) gv[bj][n] = gv[bj][n] + 1.0f;
#pragma unroll
        for (int ai = 0; ai < 2; ++ai) {
            f32x4 xv[4][2][2];
#pragma unroll
            for (int m = 0; m < 4; ++m) { const GAS float* rowp = Xin + (size_t)(rowA + ai * 128 + m * 16) * DM + colA;
#pragma unroll
                for (int bj = 0; bj < 2; ++bj)
#pragma unroll
                    for (int h = 0; h < 2; ++h) xv[m][bj][h] = *(const GAS f32x4*)(rowp + (size_t)h * 8 * DM + bj * 128); }
#pragma unroll
            for (int m = 0; m < 4; ++m) { GAS float* rowp = X + (size_t)(rowA + ai * 128 + m * 16) * DM + colA;
#pragma unroll
                for (int bj = 0; bj < 2; ++bj) {
                    const f32x4 d0 = gv[bj][0] * acc[ai][bj][m][0], d1 = gv[bj][1] * acc[ai][bj][m][1];
                    const f32x4 rcv = dpp_ror8v(lo ? d1 : d0);
                    *(GAS f32x4*)(rowp + bj * 128) = xv[m][bj][0] + (lo ? d0 : rcv);
                    *(GAS f32x4*)(rowp + (size_t)8 * DM + bj * 128) = xv[m][bj][1] + (lo ? rcv : d1);
                }
            }
            asm volatile("" ::: "memory");
        }
    }
    __device__ __forceinline__ void mid(f32x4 (&)[2][2][4][2], const Unit&, int, int, int, int) const {}
};
#define DPP_SHR1 0x111
#define DPP_SHR2 0x112
#define DPP_ROR1 0x121
#define DPP_ROR2 0x122
__device__ __forceinline__ float dpp_prev1(float cur, float prv) {
    return __builtin_bit_cast(float, __builtin_amdgcn_update_dpp(__builtin_amdgcn_update_dpp(0, __builtin_bit_cast(int, prv), DPP_ROR1, 0xf, 0xf, false), __builtin_bit_cast(int, cur), DPP_SHR1, 0xf, 0xf, false)); }
__device__ __forceinline__ float dpp_prev2(float cur, float prv) {
    return __builtin_bit_cast(float, __builtin_amdgcn_update_dpp(__builtin_amdgcn_update_dpp(0, __builtin_bit_cast(int, prv), DPP_ROR2, 0xf, 0xf, false), __builtin_bit_cast(int, cur), DPP_SHR2, 0xf, 0xf, false)); }
struct EpiConv {
    static constexpr bool PERM = true, HAS_MID = false;
    GAS bf16_t* ACT; GAS float* H0; GAS float* H1; const GAS float* cw; const GAS float* cb; LAS unsigned char* ex;
    __device__ __forceinline__ void operator()(const f32x4 (&acc)[2][2][4][2], const Unit& u, int wr, int wc, int fr, int fq) const {
        asm volatile("" : "+v"(fr), "+v"(fq));
        const int row0 = u.pm * 256 + wr * 64 + fr, chl = wc * 32 + 8 * fq, ch0 = u.pn * 128 + chl;
        f32x4 w0[2][2], w1[2][2], w2[2][2], bs[2][2];
#pragma unroll
        for (int bj = 0; bj < 2; ++bj)
#pragma unroll
            for (int n = 0; n < 2; ++n) { const int c = bj * DFF + ch0 + 4 * n;
                w0[bj][n] = *(const GAS f32x4*)(cw + c); w1[bj][n] = *(const GAS f32x4*)(cw + NUP + c); w2[bj][n] = *(const GAS f32x4*)(cw + 2 * NUP + c); bs[bj][n] = *(const GAS f32x4*)(cb + c); }
        const int slot_l = ((wc * 4 + fq) * 2) * 16;
#pragma unroll
        for (int ai = 0; ai < 2; ++ai) { const int Q = 2 * ai + wr;
            if (Q < 3 && fr >= 14) {
#pragma unroll
                for (int bj = 0; bj < 2; ++bj)
#pragma unroll
                    for (int n = 0; n < 2; ++n) *(LAS f32x4*)(ex + Q * 2048 + (fr - 14) * 1024 + bj * 512 + slot_l + n * 16) = acc[ai][bj][3][n]; } }
        if (wr == 0 && fr < 2) {
#pragma unroll
            for (int bj = 0; bj < 2; ++bj)
#pragma unroll
                for (int n = 0; n < 2; ++n) *(GAS f32x4*)(H0 + ((size_t)u.pm * 2 + fr) * NUP + u.pn * 256 + bj * 128 + chl + 4 * n) = acc[0][bj][0][n]; }
        if (wr == 1 && fr >= 14) {
#pragma unroll
            for (int bj = 0; bj < 2; ++bj)
#pragma unroll
                for (int n = 0; n < 2; ++n) *(GAS f32x4*)(H1 + ((size_t)u.pm * 2 + (fr - 14)) * NUP + u.pn * 256 + bj * 128 + chl + 4 * n) = acc[1][bj][3][n]; }
        asm volatile("s_waitcnt lgkmcnt(0)" ::: "memory");
        __builtin_amdgcn_s_barrier();
        asm volatile("" ::: "memory");
#pragma unroll
        for (int ai = 0; ai < 2; ++ai) {
            const int Q = 2 * ai + wr;
            f32x4 pv[2][2];
#pragma unroll
            for (int bj = 0; bj < 2; ++bj)
#pragma unroll
                for (int n = 0; n < 2; ++n) { pv[bj][n] = (f32x4){0.f, 0.f, 0.f, 0.f};
                    if (Q > 0 && fr >= 14) pv[bj][n] = *(const LAS f32x4*)(ex + (Q - 1) * 2048 + (fr - 14) * 1024 + bj * 512 + slot_l + n * 16); }
#pragma unroll
            for (int m = 0; m < 4; ++m) {
                f32x4 cv[2][2];
#pragma unroll
                for (int bj = 0; bj < 2; ++bj)
#pragma unroll
                    for (int n = 0; n < 2; ++n) {
                        const f32x4 cur = acc[ai][bj][m][n]; const f32x4 prv = (m == 0) ? pv[bj][n] : acc[ai][bj][m > 0 ? m - 1 : 0][n];
                        f32x4 p1, p2;
                        p1.x = dpp_prev1(cur.x, prv.x); p1.y = dpp_prev1(cur.y, prv.y); p1.z = dpp_prev1(cur.z, prv.z); p1.w = dpp_prev1(cur.w, prv.w);
                        p2.x = dpp_prev2(cur.x, prv.x); p2.y = dpp_prev2(cur.y, prv.y); p2.z = dpp_prev2(cur.z, prv.z); p2.w = dpp_prev2(cur.w, prv.w);
                        cv[bj][n] = bs[bj][n] + w0[bj][n] * p2 + w1[bj][n] * p1 + w2[bj][n] * cur;
                    }
                f32x4 o0, o1;
#pragma unroll
                for (int j = 0; j < 4; ++j) { o0[j] = cv[0][0][j] * fast_sigmoid(cv[0][0][j]) * cv[1][0][j]; o1[j] = cv[0][1][j] * fast_sigmoid(cv[0][1][j]) * cv[1][1][j]; }
                const int row = row0 + ai * 128 + m * 16;
                if (!(Q == 0 && m == 0 && fr < 2)) __builtin_nontemporal_store(pack8f(o0, o1), (GAS u32x4*)(ACT + (size_t)row * DFF + ch0));
            }
        }
    }
    __device__ __forceinline__ void mid(f32x4 (&)[2][2][4][2], const Unit&, int, int, int, int) const {}
};
constexpr int KVBLK = 64, SHM_K = KVBLK * 128 * 2, SHM_V = SHM_K;
constexpr float ATT_SCALE = 0.08838834764831845f;
#define KSWZ(row, colB) ((row) * 256 + ((colB) ^ (((row) & 7) << 4)))
__device__ __forceinline__ int v_st(int k, int c) { const int kk = (k & ~0xC) | ((k & 4) << 1) | ((k & 8) >> 1); return ((kk >> 3) * 4 + (c >> 5)) * 512 + ((kk & 7) * 32 + (c & 31)) * 2; }
__device__ __forceinline__ int v_rd_base(int lane) { return ((lane & 3) << 3) | (((lane >> 2) & 3) << 6) | (((lane >> 4) & 1) << 5) | (((lane >> 5) & 1) << 8); }
constexpr int v_rd_off(int d0, int ks, int half) { return d0 * 512 + ks * 4096 + half * 2048; }
__device__ __forceinline__ int crow(int r, int hi) { return (r & 3) + 8 * (r >> 2) + 4 * hi; }
template <int KB>
__device__ __forceinline__ void qkt(f32x16& p0, f32x16& p1, const LAS char* K_lds, int r32, int hi, const bf16x8* qr) {
    p0 = f32x16{}; p1 = f32x16{};
    int ka[4];
#pragma unroll
    for (int dd = 0; dd < 4; ++dd) ka[dd] = (int)(uintptr_t)(K_lds + KB * SHM_K + KSWZ(r32, (dd * 16 + hi * 8) * 2));
    bf16x8 fa0, fa1, fb0, fb1, fc0, fc1;
#define KRD1(dst, d0, off) asm volatile("ds_read_b128 %0, %1 offset:%2" : "=&v"(dst) : "v"(ka[(d0) & 3]), "i"(((d0) >> 2) * 128 + (off)) : "memory")
#define KRD(S, d0) do { KRD1(S##0, d0, 0); KRD1(S##1, d0, 32 * 256); } while (0)
#define KMM(S, d0, n) do { asm volatile("s_waitcnt lgkmcnt(" #n ")" ::: "memory"); SBAR(); \
        p0 = __builtin_amdgcn_mfma_f32_32x32x16_bf16(S##0, qr[d0], p0, 0, 0, 0); p1 = __builtin_amdgcn_mfma_f32_32x32x16_bf16(S##1, qr[d0], p1, 0, 0, 0); SBAR(); } while (0)
    KRD(fa, 0); KRD(fb, 1);
    KRD(fc, 2); KMM(fa, 0, 4);
    KRD(fa, 3); KMM(fb, 1, 4);
    KRD(fb, 4); KMM(fc, 2, 4);
    KRD(fc, 5); KMM(fa, 3, 4);
    KRD(fa, 6); KMM(fb, 4, 4);
    KRD(fb, 7); KMM(fc, 5, 4);
    KMM(fa, 6, 2);
    KMM(fb, 7, 0);
#undef KMM
#undef KRD
#undef KRD1
}
template <int VB>
__device__ __forceinline__ void pv_tile(f32x16* o, int vb0, bf16x8 pa0, bf16x8 pa1, bf16x8 pa2, bf16x8 pa3) {
#define TRRD(dst, off) asm volatile("ds_read_b64_tr_b16 %0, %1 offset:%2" : "=&v"(dst) : "v"(vb0), "i"(off) : "memory")
#define PV_RD(S, d0) do { constexpr int b_ = VB * SHM_V + v_rd_off(d0, 0, 0); \
        TRRD(S##l0, b_); TRRD(S##h0, b_ + 2048); TRRD(S##l1, b_ + 4096); TRRD(S##h1, b_ + 6144); TRRD(S##l2, b_ + 8192); TRRD(S##h2, b_ + 10240); TRRD(S##l3, b_ + 12288); TRRD(S##h3, b_ + 14336); } while (0)
#define PV_MM(S, d0, n) do { asm volatile("s_waitcnt lgkmcnt(" #n ")" ::: "memory"); SBAR(); \
        o[d0] = __builtin_amdgcn_mfma_f32_32x32x16_bf16(pa0, (bf16x8){S##l0[0], S##l0[1], S##l0[2], S##l0[3], S##h0[0], S##h0[1], S##h0[2], S##h0[3]}, o[d0], 0, 0, 0);   \
        o[d0] = __builtin_amdgcn_mfma_f32_32x32x16_bf16(pa1, (bf16x8){S##l1[0], S##l1[1], S##l1[2], S##l1[3], S##h1[0], S##h1[1], S##h1[2], S##h1[3]}, o[d0], 0, 0, 0);   \
        o[d0] = __builtin_amdgcn_mfma_f32_32x32x16_bf16(pa2, (bf16x8){S##l2[0], S##l2[1], S##l2[2], S##l2[3], S##h2[0], S##h2[1], S##h2[2], S##h2[3]}, o[d0], 0, 0, 0);   \
        o[d0] = __builtin_amdgcn_mfma_f32_32x32x16_bf16(pa3, (bf16x8){S##l3[0], S##l3[1], S##l3[2], S##l3[3], S##h3[0], S##h3[1], S##h3[2], S##h3[3]}, o[d0], 0, 0, 0); SBAR(); } while (0)
    s16x4 Al0, Al1, Al2, Al3, Ah0, Ah1, Ah2, Ah3, Bl0, Bl1, Bl2, Bl3, Bh0, Bh1, Bh2, Bh3;
    PV_RD(A, 0); PV_RD(B, 1);
    PV_MM(A, 0, 8);
    PV_RD(A, 2); PV_MM(B, 1, 8);
    PV_RD(B, 3); PV_MM(A, 2, 8);
    PV_MM(B, 3, 0);
#undef PV_MM
#undef PV_RD
#undef TRRD
}
__device__ __forceinline__ void pack_p(const f32x16& p0, const f32x16& p1, bf16x8& pa0, bf16x8& pa1, bf16x8& pa2, bf16x8& pa3) {
#define PK4(P, B_, OUT) do { unsigned a0 = cvtpk(P[B_+0], P[B_+1]), a1 = cvtpk(P[B_+2], P[B_+3]);                          \
        unsigned b0 = cvtpk(P[B_+4], P[B_+5]), b1 = cvtpk(P[B_+6], P[B_+7]);                                             \
        auto r0 = __builtin_amdgcn_permlane32_swap(a0, b0, false, false); auto r1 = __builtin_amdgcn_permlane32_swap(a1, b1, false, false); \
        u32x4 w = {r0[0], r1[0], r0[1], r1[1]}; OUT = *reinterpret_cast<bf16x8*>(&w); } while (0)
    PK4(p0, 0, pa0); PK4(p0, 8, pa1); PK4(p1, 0, pa2); PK4(p1, 8, pa3);
#undef PK4
}
__device__ __forceinline__ float other_half(float x, int hi) {
    auto rr = __builtin_amdgcn_permlane32_swap(__float_as_uint(x), __float_as_uint(x), false, false);
    return __uint_as_float(hi ? rr[0] : rr[1]);
}

__device__ __forceinline__ void store_o(const f32x16* o, GAS bf16_t* Ow, int r32, int hi, const float* rscale  ) {
#pragma unroll
    for (int r = 0; r < 16; ++r) { const int orow = crow(r, hi);
#pragma unroll
        for (int d0 = 0; d0 < 4; ++d0) { const float v = rscale ? o[d0][r] * rscale[r] : o[d0][r];
            const float vn = __shfl_xor(v, 1);
            if ((r32 & 1) == 0) *(GAS unsigned*)(Ow + (size_t)orow * DM + d0 * 32 + r32) = cvtpk(v, vn); } }
}

constexpr int ATT_LDS_WS = 2 * SHM_V + 2 * SHM_K;
__device__ __forceinline__ void sb_attn_unit(LAS char* lds, const GAS bf16_t* proj, GAS bf16_t* Y, int b, int h, int qb) {
    int tid = threadIdx.x; asm volatile("" : "+v"(tid));
    const int wid = __builtin_amdgcn_readfirstlane(tid >> 6), lane = tid & 63, r32 = lane & 31, hi = lane >> 5;
    LAS char* V_lds = lds; LAS char* K_lds = lds + 2 * SHM_V;
    volatile LAS unsigned* flags = (volatile LAS unsigned*)(lds + ATT_LDS_WS + 8 * 256);
    const int q0 = qb * 256, qlo = q0 + wid * 32, trow = qlo + r32;
    const GAS bf16_t* Qp = proj + (size_t)(b * SEQ + q0) * LDP + C_QSB + h * 128;
    const GAS bf16_t* Kp = proj + (size_t)(b * SEQ) * LDP + C_KSB + h * 128;
    const GAS bf16_t* Vp = proj + (size_t)(b * SEQ) * LDP + C_VSB + h * 128;
    bf16x8 qr[8];
#pragma unroll
    for (int d0 = 0; d0 < 8; ++d0) qr[d0] = *(const GAS bf16x8*)(Qp + (size_t)(wid * 32 + r32) * LDP + d0 * 16 + hi * 8);
    const int NT = qb * 4 + 4;
    const int sr = tid >> 4, sc = (tid & 15) * 8, vst0 = v_st(sr, sc), vst1 = v_st(32 + sr, sc), kws = KSWZ(sr, sc * 2);
    const int vb0 = (int)(uintptr_t)V_lds + v_rd_base(lane);
    bf16x8 st_k0, st_k1, st_v0, st_v1;
#define SB_LOAD(k0) do { st_v0 = *(const GAS bf16x8*)(Vp + (size_t)((k0) + sr) * LDP + sc); st_v1 = *(const GAS bf16x8*)(Vp + (size_t)((k0) + 32 + sr) * LDP + sc); \
                         st_k0 = *(const GAS bf16x8*)(Kp + (size_t)((k0) + sr) * LDP + sc); st_k1 = *(const GAS bf16x8*)(Kp + (size_t)((k0) + 32 + sr) * LDP + sc); } while (0)
#define SB_WRITE(bf) do { *(LAS bf16x8*)(V_lds + (bf) * SHM_V + vst0) = st_v0; *(LAS bf16x8*)(V_lds + (bf) * SHM_V + vst1) = st_v1; \
                          *(LAS bf16x8*)(K_lds + (bf) * SHM_K + kws) = st_k0; *(LAS bf16x8*)(K_lds + (bf) * SHM_K + kws + 32 * 256) = st_k1; } while (0)
    f32x16 o[4] = {};
    float C = 0.f;
    SB_LOAD((NT - 1) * 64); VM_WAIT(); SB_WRITE(0);
    if (NT > 1) SB_LOAD((NT - 2) * 64);
    __syncthreads();
    int it = 0;
    constexpr float C2S = ATT_SCALE * 1.4426950408889634f;
    for (;;) {
#define SB_BODY(BUF) { \
        const int kb = (NT - 1 - it) * 64; const bool has_next = (it + 1 < NT); \
        if (has_next) { VM_WAIT(); SB_WRITE((BUF) ^ 1); } \
        if (it + 2 < NT) SB_LOAD(kb - 128); \
        if (kb < qlo + 31) { \
            f32x16 p0, p1; qkt<BUF>(p0, p1, K_lds, r32, hi, qr); \
            const int dq = trow - kb - 4 * hi; \
            float Lv[32]; \
            const bool diag = (kb + 63 >= qlo);            \
            _Pragma("unroll") for (int r = 0; r < 16; ++r) { const int c = (r & 3) + 8 * (r >> 2); \
                { const float z = p0[r] * C2S; const float L = fmaxf(z, 0.f) + __builtin_amdgcn_logf(1.f + __builtin_amdgcn_exp2f(-fabsf(z))); const bool v = c < dq; Lv[r] = v ? L : 0.f; p0[r] = z - L; } \
                { const float z = p1[r] * C2S; const float L = fmaxf(z, 0.f) + __builtin_amdgcn_logf(1.f + __builtin_amdgcn_exp2f(-fabsf(z))); const bool v = (c + 32) < dq; Lv[16 + r] = v ? L : 0.f; p1[r] = z - L; } } \
              \
            float T[8], Tb[8], S[8]; \
            _Pragma("unroll") for (int q = 0; q < 8; ++q) T[q] = (Lv[4 * q] + Lv[4 * q + 1]) + (Lv[4 * q + 2] + Lv[4 * q + 3]); \
            _Pragma("unroll") for (int q = 0; q < 8; ++q) Tb[q] = other_half(T[q], hi); \
            float run = C; \
            _Pragma("unroll") for (int q = 7; q >= 0; --q) { S[q] = run + (hi ? 0.f : Tb[q]); run += T[q] + Tb[q]; } \
            C = run; \
            _Pragma("unroll") for (int q = 0; q < 8; ++q) { \
                const float e3 = S[q], e2 = e3 + Lv[4 * q + 3], e1 = e2 + Lv[4 * q + 2], e0 = e1 + Lv[4 * q + 1]; \
                const int cb = (q & 3) * 8 + (q >> 2) * 32; \
                if (q < 4) { p0[4 * q + 0] = __builtin_amdgcn_exp2f(p0[4 * q + 0] - e0); p0[4 * q + 1] = __builtin_amdgcn_exp2f(p0[4 * q + 1] - e1); \
                             p0[4 * q + 2] = __builtin_amdgcn_exp2f(p0[4 * q + 2] - e2); p0[4 * q + 3] = __builtin_amdgcn_exp2f(p0[4 * q + 3] - e3); } \
                else { const int qq = q - 4; \
                             p1[4 * qq + 0] = __builtin_amdgcn_exp2f(p1[4 * qq + 0] - e0); p1[4 * qq + 1] = __builtin_amdgcn_exp2f(p1[4 * qq + 1] - e1); \
                             p1[4 * qq + 2] = __builtin_amdgcn_exp2f(p1[4 * qq + 2] - e2); p1[4 * qq + 3] = __builtin_amdgcn_exp2f(p1[4 * qq + 3] - e3); } } \
            if (diag) { _Pragma("unroll") for (int r = 0; r < 16; ++r) { const int c = (r & 3) + 8 * (r >> 2); p0[r] = (c < dq) ? p0[r] : 0.f; p1[r] = ((c + 32) < dq) ? p1[r] : 0.f; } } \
            bf16x8 pa0, pa1, pa2, pa3; pack_p(p0, p1, pa0, pa1, pa2, pa3); \
            pv_tile<BUF>(o, vb0, pa0, pa1, pa2, pa3); \
        } \
        { const bool done = __all(C > 160.f); if (lane == 0) flags[(it & 1) * 8 + wid] = done ? 1u : 0u; } \
        __syncthreads(); \
        ++it; if (it >= NT) break; \
        { unsigned all = 1u; _Pragma("unroll") for (int w = 0; w < 8; ++w) all &= flags[((it - 1) & 1) * 8 + w]; if (all) break; } }
        SB_BODY(0)
        SB_BODY(1)
#undef SB_BODY
    }
    store_o(o, Y + (size_t)(b * SEQ + qlo) * DM + h * 128, r32, hi, nullptr);
    __syncthreads();
#undef SB_LOAD
#undef SB_WRITE
}

constexpr float DSA_THR = 8.f;
__device__ __forceinline__ float dsa_msk(float p, int m, int c) { const int s = __builtin_amdgcn_sbfe(m, c, 1); return __builtin_bit_cast(float, (__builtin_bit_cast(int, p) & s) | (~s & (int)0xFF800000)); }
__device__ __forceinline__ void dsa_attn_unit(LAS char* lds, const GAS bf16_t* proj, const GAS unsigned long long* maskw, GAS bf16_t* Y, int b, int h, int qb) {
    int tid = threadIdx.x; asm volatile("" : "+v"(tid));
    const int wid = __builtin_amdgcn_readfirstlane(tid >> 6), lane = tid & 63, r32 = lane & 31, hi = lane >> 5;
    LAS char* V_lds = lds; LAS char* K_lds = lds + 2 * SHM_V;
    LAS float* ws = (LAS float*)(lds + ATT_LDS_WS) + wid * 64; LAS float* li_l = ws; LAS float* al_l = ws + 32;
    const int q0 = qb * 256, qlo = q0 + wid * 32, trow = qlo + r32;
    const GAS bf16_t* Qp = proj + (size_t)(b * SEQ + q0) * LDP + C_QD + h * 128;
    const GAS bf16_t* Kp = proj + (size_t)(b * SEQ) * LDP + C_KD + h * 128;
    const GAS bf16_t* Vp = proj + (size_t)(b * SEQ) * LDP + C_VD + h * 128;
    const GAS unsigned long long* mrow = maskw + (size_t)(b * SEQ + trow) * 32;
    bf16x8 qr[8];
#pragma unroll
    for (int d0 = 0; d0 < 8; ++d0) qr[d0] = *(const GAS bf16x8*)(Qp + (size_t)(wid * 32 + r32) * LDP + d0 * 16 + hi * 8);
    const int NT = qb * 4 + 4;
    const int sr = tid >> 4, sc = (tid & 15) * 8, vst0 = v_st(sr, sc), vst1 = v_st(32 + sr, sc), kws = KSWZ(sr, sc * 2);
    const int vb0 = (int)(uintptr_t)V_lds + v_rd_base(lane);
    bf16x8 st_k0, st_k1, st_v0, st_v1;
#define DS_LOAD(k0) do { st_v0 = *(const GAS bf16x8*)(Vp + (size_t)((k0) + sr) * LDP + sc); st_v1 = *(const GAS bf16x8*)(Vp + (size_t)((k0) + 32 + sr) * LDP + sc); \
                         st_k0 = *(const GAS bf16x8*)(Kp + (size_t)((k0) + sr) * LDP + sc); st_k1 = *(const GAS bf16x8*)(Kp + (size_t)((k0) + 32 + sr) * LDP + sc); } while (0)
#define DS_WRITE(bf) do { *(LAS bf16x8*)(V_lds + (bf) * SHM_V + vst0) = st_v0; *(LAS bf16x8*)(V_lds + (bf) * SHM_V + vst1) = st_v1; \
                          *(LAS bf16x8*)(K_lds + (bf) * SHM_K + kws) = st_k0; *(LAS bf16x8*)(K_lds + (bf) * SHM_K + kws + 32 * 256) = st_k1; } while (0)
    f32x16 o[4] = {};
    float m_reg = -1e30f, l_reg = 0.f;
    unsigned long long mw = mrow[0], mw_next = 0ull;
    DS_LOAD(0); VM_WAIT(); DS_WRITE(0);
    if (NT > 1) DS_LOAD(64);
    __syncthreads();
    constexpr float C2 = 1.4426950408889634f * ATT_SCALE;
    int it = 0;
    for (;;) {
#define DS_BODY(BUF) { \
        const int kb = it * 64; const bool has_next = (it + 1 < NT); \
        if (has_next) { VM_WAIT(); DS_WRITE((BUF) ^ 1); mw_next = mrow[it + 1]; }        \
        if (it + 2 < NT) DS_LOAD(kb + 128); \
        if (kb <= qlo + 31) { \
            f32x16 p0, p1; qkt<BUF>(p0, p1, K_lds, r32, hi, qr); \
            const int m0 = (int)((unsigned)mw >> (4 * hi)), m1 = (int)((unsigned)(mw >> 32) >> (4 * hi)); \
              \
            p0[0] = dsa_msk(p0[0], m0, 0); p1[0] = dsa_msk(p1[0], m1, 0); \
            p0[1] = dsa_msk(p0[1], m0, 1); p1[1] = dsa_msk(p1[1], m1, 1); \
            p0[2] = dsa_msk(p0[2], m0, 2); p1[2] = dsa_msk(p1[2], m1, 2); \
            p0[3] = dsa_msk(p0[3], m0, 3); p1[3] = dsa_msk(p1[3], m1, 3); \
            p0[4] = dsa_msk(p0[4], m0, 8); p1[4] = dsa_msk(p1[4], m1, 8); \
            p0[5] = dsa_msk(p0[5], m0, 9); p1[5] = dsa_msk(p1[5], m1, 9); \
            p0[6] = dsa_msk(p0[6], m0, 10); p1[6] = dsa_msk(p1[6], m1, 10); \
            p0[7] = dsa_msk(p0[7], m0, 11); p1[7] = dsa_msk(p1[7], m1, 11); \
            p0[8] = dsa_msk(p0[8], m0, 16); p1[8] = dsa_msk(p1[8], m1, 16); \
            p0[9] = dsa_msk(p0[9], m0, 17); p1[9] = dsa_msk(p1[9], m1, 17); \
            p0[10] = dsa_msk(p0[10], m0, 18); p1[10] = dsa_msk(p1[10], m1, 18); \
            p0[11] = dsa_msk(p0[11], m0, 19); p1[11] = dsa_msk(p1[11], m1, 19); \
            p0[12] = dsa_msk(p0[12], m0, 24); p1[12] = dsa_msk(p1[12], m1, 24); \
            p0[13] = dsa_msk(p0[13], m0, 25); p1[13] = dsa_msk(p1[13], m1, 25); \
            p0[14] = dsa_msk(p0[14], m0, 26); p1[14] = dsa_msk(p1[14], m1, 26); \
            p0[15] = dsa_msk(p0[15], m0, 27); p1[15] = dsa_msk(p1[15], m1, 27); \
            float pmax = p0[0]; \
            _Pragma("unroll") for (int r = 1; r < 16; ++r) pmax = fmaxf(pmax, p0[r]); \
            _Pragma("unroll") for (int r = 0; r < 16; ++r) pmax = fmaxf(pmax, p1[r]); \
            pmax = fmaxf(pmax, other_half(pmax, hi)); \
            float mn, alpha; \
            if (__all((pmax - m_reg) * ATT_SCALE <= DSA_THR)) { mn = m_reg; alpha = 1.f; } \
            else { mn = fmaxf(m_reg, pmax); alpha = __builtin_amdgcn_exp2f((m_reg - mn) * C2); m_reg = mn; } \
            const float mnL = -mn * C2; \
            _Pragma("unroll") for (int r = 0; r < 16; ++r) { p0[r] = __builtin_amdgcn_exp2f(fmaf(p0[r], C2, mnL)); p1[r] = __builtin_amdgcn_exp2f(fmaf(p1[r], C2, mnL)); } \
            float ps = 0.f; \
            _Pragma("unroll") for (int r = 0; r < 16; ++r) ps += p0[r] + p1[r]; \
            ps += other_half(ps, hi); \
            l_reg = l_reg * alpha + ps; \
            if (__any(alpha < 1.f)) { if (hi == 0) al_l[r32] = alpha; LDS_WAIT(); \
                _Pragma("unroll") for (int r = 0; r < 16; ++r) { const float a_ = al_l[crow(r, hi)]; o[0][r] *= a_; o[1][r] *= a_; o[2][r] *= a_; o[3][r] *= a_; } } \
            bf16x8 pa0, pa1, pa2, pa3; pack_p(p0, p1, pa0, pa1, pa2, pa3); \
            pv_tile<BUF>(o, vb0, pa0, pa1, pa2, pa3); \
        } \
        if (has_next) mw = mw_next; \
        __syncthreads(); \
        ++it; if (it >= NT) break; }
        DS_BODY(0)
        DS_BODY(1)
#undef DS_BODY
    }
    if (hi == 0) li_l[r32] = l_reg; LDS_WAIT();
    float rli[16];
#pragma unroll
    for (int r = 0; r < 16; ++r) rli[r] = __builtin_amdgcn_rcpf(li_l[crow(r, hi)]);
    store_o(o, Y + (size_t)(b * SEQ + qlo) * DM + 1024 + h * 128, r32, hi, rli);
    __syncthreads();
#undef DS_LOAD
#undef DS_WRITE
}

__device__ __forceinline__ void cnt8v(int& a0, int& a1, int& a2, int& a3, unsigned k0, unsigned k1, unsigned k2, unsigned k3, unsigned k4, unsigned k5, unsigned k6, unsigned k7, unsigned cand) {
    asm volatile(
        "v_cmp_ge_u32_e64 s[36:37], %4, %12\n\t"
        "v_cmp_ge_u32_e64 s[38:39], %5, %12\n\t"
        "v_cmp_ge_u32_e64 s[40:41], %6, %12\n\t"
        "v_cmp_ge_u32_e64 s[42:43], %7, %12\n\t"
        "v_cmp_ge_u32_e64 s[44:45], %8, %12\n\t"
        "v_cmp_ge_u32_e64 s[46:47], %9, %12\n\t"
        "v_cmp_ge_u32_e64 s[48:49], %10, %12\n\t"
        "v_cmp_ge_u32_e64 s[50:51], %11, %12\n\t"
        "v_addc_co_u32_e64 %0, s[52:53], 0, %0, s[36:37]\n\t"
        "v_addc_co_u32_e64 %1, s[52:53], 0, %1, s[38:39]\n\t"
        "v_addc_co_u32_e64 %2, s[52:53], 0, %2, s[40:41]\n\t"
        "v_addc_co_u32_e64 %3, s[52:53], 0, %3, s[42:43]\n\t"
        "v_addc_co_u32_e64 %0, s[52:53], 0, %0, s[44:45]\n\t"
        "v_addc_co_u32_e64 %1, s[52:53], 0, %1, s[46:47]\n\t"
        "v_addc_co_u32_e64 %2, s[52:53], 0, %2, s[48:49]\n\t"
        "v_addc_co_u32_e64 %3, s[52:53], 0, %3, s[50:51]\n\t"
        : "+v"(a0), "+v"(a1), "+v"(a2), "+v"(a3)
        : "v"(k0), "v"(k1), "v"(k2), "v"(k3), "v"(k4), "v"(k5), "v"(k6), "v"(k7), "v"(cand)
        : "s36", "s37", "s38", "s39", "s40", "s41", "s42", "s43", "s44", "s45", "s46", "s47", "s48", "s49", "s50", "s51", "s52", "s53");
}
__device__ __forceinline__ void idxsel_pair(const GAS bf16_t* proj, const GAS bf16_t* kix, GAS unsigned long long* maskw, int b, int t0, int lane, LAS unsigned* kl  ) {
    asm volatile("" : "+v"(lane));
    const int r32 = lane & 31, hi = lane >> 5, t = t0 + hi;
    GAS unsigned long long* mrow = maskw + (size_t)(b * SEQ + t) * 32 + r32;
    if (t0 + 1 < 255) {
        const int lo = 64 * r32; *mrow = (t >= lo + 63) ? ~0ull : (t < lo ? 0ull : ((2ull << (t - lo)) - 1ull));
        return;
    }
    const int NKT = (t0 >> 5) + 1, NG = (NKT + 3) >> 2;
    {
        const int tl = (r32 >> 2) & 1, hh = 4 * (r32 >> 3) + (r32 & 3);
        bf16x8 af[4]; float wf[16];
        const GAS bf16_t* ap = proj + (size_t)(b * SEQ + t0 + tl) * LDP + C_QI + hh * 64 + hi * 8;
#pragma unroll
        for (int ks = 0; ks < 4; ++ks) af[ks] = *(const GAS bf16x8*)(ap + ks * 16);
        const GAS bf16_t* wp = proj + (size_t)(b * SEQ + t) * LDP + C_WI;
        const u32x4 w0 = *(const GAS u32x4*)wp, w1 = *(const GAS u32x4*)(wp + 8);
#pragma unroll
        for (int q = 0; q < 4; ++q) { wf[2 * q] = bf_lo(w0[q]); wf[2 * q + 1] = bf_hi(w0[q]); wf[8 + 2 * q] = bf_lo(w1[q]); wf[8 + 2 * q + 1] = bf_hi(w1[q]); }
        const GAS bf16_t* kp = kix + (size_t)b * (SEQ / 32) * 2048 + lane * 8;
        bf16x8 bc[4], bn[4];
#pragma unroll
        for (int ks = 0; ks < 4; ++ks) bc[ks] = *(const GAS bf16x8*)(kp + ks * 512);
        for (int g = 0; g < NG; ++g) {
            u32x4 kq = {0u, 0u, 0u, 0u};
#pragma unroll
            for (int i = 0; i < 4; ++i) {
                const int kt = 4 * g + i;
                if (kt < NKT) {
                    const bool more = (kt + 1 < NKT);
                    if (more) {
#pragma unroll
                        for (int ks = 0; ks < 4; ++ks) bn[ks] = *(const GAS bf16x8*)(kp + (size_t)(kt + 1) * 2048 + ks * 512);
                    }
                    f32x16 acc = {};
#pragma unroll
                    for (int ks = 0; ks < 4; ++ks) acc = __builtin_amdgcn_mfma_f32_32x32x16_bf16(af[ks], bc[ks], acc, 0, 0, 0);
                    float sc = 0.f;
#pragma unroll
                    for (int r = 0; r < 16; ++r) sc = fmaf(wf[r], fmaxf(acc[r], 0.f), sc);
                    const unsigned u = __float_as_uint(sc);
                    unsigned kv = (u >> 31) ? ~u : (u | 0x80000000u);
                    if (32 * kt + r32 > t) kv = 0u;
                    kq[i] = kv;
                    if (more) {
#pragma unroll
                        for (int ks = 0; ks < 4; ++ks) bc[ks] = bn[ks];
                    }
                }
            }
            *(LAS u32x4*)(kl + (g * 64 + lane) * 4) = kq;
        }
    }
    LDS_WAIT(); asm volatile("" ::: "memory");
    unsigned key[64];
#pragma unroll
    for (int g = 0; g < 16; ++g) { u32x4 kq = {0u, 0u, 0u, 0u}; if (g < NG) kq = *(const LAS u32x4*)(kl + (g * 64 + lane) * 4);
        key[4 * g] = kq[0]; key[4 * g + 1] = kq[1]; key[4 * g + 2] = kq[2]; key[4 * g + 3] = kq[3]; }
    unsigned T = 0u; bool done = false;
    for (int bit = 31; bit >= 0; --bit) {
        const unsigned cand = T | (1u << bit);
        int c0 = 0, c1 = 0, c2 = 0, c3 = 0;
#pragma unroll
        for (int g = 0; g < 8; ++g) { if (g * 8 < NKT) cnt8v(c0, c1, c2, c3, key[8 * g], key[8 * g + 1], key[8 * g + 2], key[8 * g + 3], key[8 * g + 4], key[8 * g + 5], key[8 * g + 6], key[8 * g + 7], cand); }
        int x = (c0 + c1) + (c2 + c3);
        x += __builtin_amdgcn_update_dpp(0, x, 0xB1, 0xf, 0xf, false);
        x += __builtin_amdgcn_update_dpp(0, x, 0x4E, 0xf, 0xf, false);
        x += __builtin_amdgcn_update_dpp(0, x, 0x141, 0xf, 0xf, false);
        x += __builtin_amdgcn_update_dpp(0, x, 0x140, 0xf, 0xf, false);
        const int q0 = __builtin_amdgcn_readlane(x, 0) + __builtin_amdgcn_readlane(x, 16), q1 = __builtin_amdgcn_readlane(x, 32) + __builtin_amdgcn_readlane(x, 48);
        const int cnt = hi ? q1 : q0;
        if (!done && cnt >= 256) T = cand;
        done = done || (cnt == 256);
        if (__all(done)) break;
    }
    unsigned lo_w = 0u, hi_w = 0u;
#pragma unroll
    for (int j = 0; j < 32; ++j) {
        if (2 * j < NKT) {
            const unsigned long long b0 = __ballot(key[2 * j] >= T && key[2 * j] != 0u), b1 = __ballot(key[2 * j + 1] >= T && key[2 * j + 1] != 0u);
            const unsigned a_lo = hi ? (unsigned)(b0 >> 32) : (unsigned)b0, a_hi = hi ? (unsigned)(b1 >> 32) : (unsigned)b1;
            lo_w = (r32 == j) ? a_lo : lo_w; hi_w = (r32 == j) ? a_hi : hi_w;
        }
    }
    *mrow = (unsigned long long)lo_w | ((unsigned long long)hi_w << 32);
}

constexpr int RING_BYTES = 131072, LDSCTL_OFF = RING_BYTES, MISC_OFF = LDSCTL_OFF + 320, LDS_BYTES = 147456;
constexpr int NPHASE = 2 + 11 * DEPTH + 1;
constexpr int CW_BAR = 4096;
static_assert((CW_BAR + NPHASE * XCD_BAR_WORDS) * 4 <= (int)CTL_BYTES, "ctl");

struct Args { const float* in[16]; float* out; unsigned char* ws; int ph_lo, ph_hi, li, pad; };

template <int MAP>
__device__ __forceinline__ int src_col(int n) {
    if (MAP == 0) return n;
    if (MAP == 2) { const int pn = n >> 8, bj = (n >> 7) & 1, cc = n & 127; return bj * DFF + pn * 128 + cc; }
    if (n < 3072) return n;
    if (n < 5120) { const int base = n & ~127, p = n & 127, g = p >> 3, j = p & 7; return base + ((j < 4) ? 4 * g + j : 64 + 4 * g + (j - 4)); }
    if (n < 6144) return n;
    if (n < 7168) { const int base = n & ~63, p = n & 63, g = p >> 3, j = p & 7; return base + ((j < 4) ? 4 * g + j : 32 + 4 * g + (j - 4)); }
    if (n < 9216) return 7248 + (n - 7168);
    if (n < 11264) return 9296 + (n - 9216);
    if (n < 11328) { const int p = n - 11264, g = p >> 3, j = p & 7; return 7168 + ((j < 4) ? 4 * g + j : 32 + 4 * g + (j - 4)); }
    if (n < 11344) return 7232 + (n - 11328);
    return -1;
}
template <int MAP>
__device__ __forceinline__ void convert_item(const GAS float* W, int Nsrc, GAS bf16_t* WT, int ldk, int kdst, int nblk, int item, int lane) {
    const int kb = item / nblk, nb = item % nblk, k0 = 32 * kb, n = 64 * nb + lane;
    const int sc_ = src_col<MAP>(n);
    const GAS float* wp = W + (size_t)k0 * Nsrc + (sc_ >= 0 ? sc_ : 0);
    float v[32];
#pragma unroll
    for (int i = 0; i < 32; ++i) v[i] = __builtin_nontemporal_load(wp + (size_t)i * Nsrc);
    if (sc_ < 0) {
#pragma unroll
        for (int i = 0; i < 32; ++i) v[i] = 0.f;
    }
    GAS u32x4* op = (GAS u32x4*)(WT + (size_t)n * ldk + kdst + k0);
#pragma unroll
    for (int g = 0; g < 4; ++g) { u32x4 o = {cvtpk(v[8 * g], v[8 * g + 1]), cvtpk(v[8 * g + 2], v[8 * g + 3]), cvtpk(v[8 * g + 4], v[8 * g + 5]), cvtpk(v[8 * g + 6], v[8 * g + 7])}; op[g] = o; }
}

typedef const __attribute__((address_space(4))) Args* KArgs;
__device__ __forceinline__ KArgs kargs() { KArgs k = (KArgs)__builtin_amdgcn_kernarg_segment_ptr(); asm volatile("" : "+s"(k)); return k; }
#define KIN(i) ((const GAS float*)kargs()->in[i])
#define WSP(T, off) ((GAS T*)((GAS unsigned char*)kargs()->ws + (off)))

template <bool COPY>
__device__ __forceinline__ void norm_rows(const GAS float* xsrc, const GAS float* gain, const GAS float* modb  ,
                                          GAS bf16_t* hb, GAS float* copy_to, int gw, int NGW, int lane) {
    for (int wv = gw; wv < NBATCH * 128; wv += NGW) {
        const int b = wv >> 7, rb = wv & 127;
        f32x4 gm[8], sh[8];
        { const GAS f32x4* gp = (const GAS f32x4*)gain + lane; const GAS f32x4* shp = (const GAS f32x4*)(modb + (size_t)b * NMOD) + lane; const GAS f32x4* scp = (const GAS f32x4*)(modb + (size_t)b * NMOD + DM) + lane;
#pragma unroll
          for (int j = 0; j < 8; ++j) { gm[j] = gp[64 * j] * (scp[64 * j] + 1.0f); sh[j] = shp[64 * j]; } }
        f32x4 cur[8], nxt[8];
        { const GAS f32x4* xr = (const GAS f32x4*)(xsrc + (size_t)(b * SEQ + rb) * DM) + lane;
#pragma unroll
          for (int j = 0; j < 8; ++j) cur[j] = __builtin_nontemporal_load(xr + 64 * j); }
        for (int k = 0; k < 16; ++k) {
            const int row = b * SEQ + rb + 128 * k;
            if (k + 1 < 16) { const GAS f32x4* xr = (const GAS f32x4*)(xsrc + (size_t)(row + 128) * DM) + lane;
#pragma unroll
                for (int j = 0; j < 8; ++j) nxt[j] = __builtin_nontemporal_load(xr + 64 * j); }
            float ss = 0.f;
#pragma unroll
            for (int j = 0; j < 8; ++j) ss += (cur[j][0] * cur[j][0] + cur[j][1] * cur[j][1]) + (cur[j][2] * cur[j][2] + cur[j][3] * cur[j][3]);
            const float rs = 1.f / sqrtf(wave_sum(ss) * (1.f / DM) + NORM_EPS);
            GAS u32x2* op = (GAS u32x2*)(hb + (size_t)row * DM) + lane;
#pragma unroll
            for (int j = 0; j < 8; ++j) {
                const f32x4 hv = cur[j] * rs * gm[j] + sh[j];
                u32x2 o2; o2.x = cvtpk(hv[0], hv[1]); o2.y = cvtpk(hv[2], hv[3]); op[64 * j] = o2;
                if (COPY) ((GAS f32x4*)(copy_to + (size_t)row * DM) + lane)[64 * j] = cur[j];
            }
#pragma unroll
            for (int j = 0; j < 8; ++j) cur[j] = nxt[j];
        }
    }
}

__global__ void __launch_bounds__(512, 2) fwd(Args args) {
    extern __shared__ __attribute__((aligned(16))) unsigned char lds_raw[];
    LAS unsigned char* lds = (LAS unsigned char*)lds_raw;
    volatile LAS unsigned* MISC = (volatile LAS unsigned*)(lds + MISC_OFF);
    const int G = gridDim.x; const int bx = blockIdx.x;
    const int vcu = (G % 8 == 0) ? (bx % 8) * (G / 8) + bx / 8 : bx;
    const int NGW = G * 8;
#define PHASE_IDS() int tid = threadIdx.x; asm volatile("" : "+v"(tid)); const int lane = tid & 63, wave = __builtin_amdgcn_readfirstlane(tid >> 6); const int gw = vcu * 8 + wave; (void)lane; (void)gw

    { PHASE_IDS(); for (int u = tid; u < (LDS_BYTES - LDSCTL_OFF) / 4; u += 512) ((LAS unsigned*)(lds + LDSCTL_OFF))[u] = 0u; }
    __syncthreads();
    const int lo = args.ph_lo, hi_ph = args.ph_hi;
    XcdBarrier bar; bar.bar = (unsigned*)(args.ws + WS_CTL) + CW_BAR + args.li * XCD_BAR_WORDS; bar.x = 0; bar.st = nullptr;
    if (hi_ph - lo > 1) bar = xcd_barrier_post((unsigned*)(args.ws + WS_CTL) + CW_BAR + args.li * XCD_BAR_WORDS, MISC + 8);
#ifndef AUDIT_MASK
#define AUDIT_MASK 0xFFFF
#endif
#define PH_ON(s) ((AUDIT_MASK >> (s)) & 1)
#define IN(k) (lo <= (k) && (k) < hi_ph)
#define SEAM(k) do { if (IN(k) && IN((k) + 1)) xcd_barrier(bar); } while (0)

    if (PH_ON(0) && IN(0)) {
            PHASE_IDS();
        const GAS float* c_in = KIN(1); const GAS int* positions = (const GAS int*)KIN(2); const GAS float* w_ada = KIN(7);
        GAS float* MODP = WSP(float, WS_ACT);
        LAS float* scl = (LAS float*)lds;
        for (int i0 = tid; i0 < NBATCH * DM; i0 += 512 * 16) {
            float cv_[16];
#pragma unroll
            for (int u = 0; u < 16; ++u) cv_[u] = c_in[i0 + u * 512];
#pragma unroll
            for (int u = 0; u < 16; ++u) { const int i = i0 + u * 512, b = i >> 11, k = i & (DM - 1); const float v = cv_[u]; scl[k * 16 + b] = v * fast_sigmoid(v); }
        }
        __syncthreads();
        for (int item = gw; item < DEPTH * 48 * 8; item += NGW) {
            const int kc = item & 7, rem = item >> 3, nb = rem % 48, l = rem / 48, n = nb * 256 + lane * 4;
            const GAS float* Wp = w_ada + ((size_t)l * DM + kc * 256) * NMOD + n;
            f32x4 acc[16];
#pragma unroll
            for (int b = 0; b < 16; ++b) acc[b] = (f32x4){0.f, 0.f, 0.f, 0.f};
            for (int k0 = 0; k0 < 256; k0 += 4, Wp += (size_t)4 * NMOD) {
                asm volatile("" : "+v"(Wp));
                f32x4 wv_[4];
#pragma unroll
                for (int u = 0; u < 4; ++u) wv_[u] = __builtin_nontemporal_load((const GAS f32x4*)(Wp + (size_t)u * NMOD));
#pragma unroll
                for (int u = 0; u < 4; ++u) {
                    const LAS f32x4* s4 = (const LAS f32x4*)(scl + (kc * 256 + k0 + u) * 16);
                    const f32x4 s0 = s4[0], s1 = s4[1], s2 = s4[2], s3 = s4[3];
#pragma unroll
                    for (int j = 0; j < 4; ++j) { acc[j] += wv_[u] * s0[j]; acc[4 + j] += wv_[u] * s1[j]; acc[8 + j] += wv_[u] * s2[j]; acc[12 + j] += wv_[u] * s3[j]; }
                }
            }
#pragma unroll
            for (int b = 0; b < 16; ++b) *(GAS f32x4*)(MODP + ((size_t)(kc * DEPTH + l) * 16 + b) * NMOD + n) = acc[b];
        }
        GAS float* COS128 = WSP(float, WS_COS128); GAS float* SIN128 = WSP(float, WS_SIN128); GAS float* COS64 = WSP(float, WS_COS64); GAS float* SIN64 = WSP(float, WS_SIN64);
        int pos_nx = positions[(bx * 512 + tid) / 96];
        for (int i = bx * 512 + tid; i < MTOK * 96; i += G * 512) {
            const int tok = i / 96, j = i % 96;
            const int pos_cur = pos_nx; { const int i2 = i + G * 512; if (i2 < MTOK * 96) pos_nx = positions[i2 / 96]; }
            const int e = (j < 64) ? j : 2 * (j - 64);
            double inv = 1.0, p = 0.8659643233600653;
            for (int q = 0; q < 6; ++q) { if ((e >> q) & 1) inv *= p; p *= p; }
            const double ang = (double)pos_cur * inv;
            const double kq = __builtin_rint(ang * 0.6366197723675814);
            double r = __builtin_fma(-kq, 1.5707963267948966, ang); r = __builtin_fma(-kq, 6.123233995736766e-17, r);
            const double r2 = r * r;
            double sn = -1.0 / 1307674368000.0; sn = sn * r2 + 1.0 / 6227020800.0; sn = sn * r2 - 1.0 / 39916800.0; sn = sn * r2 + 1.0 / 362880.0; sn = sn * r2 - 1.0 / 5040.0; sn = sn * r2 + 1.0 / 120.0; sn = sn * r2 - 1.0 / 6.0; sn = sn * r2 * r + r;
            double cs = 1.0 / 20922789888000.0; cs = cs * r2 - 1.0 / 87178291200.0; cs = cs * r2 + 1.0 / 479001600.0; cs = cs * r2 - 1.0 / 3628800.0; cs = cs * r2 + 1.0 / 40320.0; cs = cs * r2 - 1.0 / 720.0; cs = cs * r2 + 1.0 / 24.0; cs = cs * r2 - 0.5; cs = cs * r2 + 1.0;
            const int qd = ((int)(long long)kq) & 3;
            const double cc = (qd == 0) ? cs : (qd == 1) ? -sn : (qd == 2) ? -cs : sn;
            const double ss = (qd == 0) ? sn : (qd == 1) ? cs : (qd == 2) ? -sn : -cs;
            if (j < 64) { COS128[(size_t)tok * 64 + j] = (float)cc; SIN128[(size_t)tok * 64 + j] = (float)ss; }
            else { COS64[(size_t)tok * 32 + (j - 64)] = (float)cc; SIN64[(size_t)tok * 32 + (j - 64)] = (float)ss; }
        }
        __syncthreads();
    }
    SEAM(0);
    if (PH_ON(1) && IN(1)) {
            PHASE_IDS();
        const GAS float* b_ada = KIN(8); const GAS float* MODP = WSP(float, WS_ACT); GAS float* MOD = WSP(float, WS_MOD);
        for (int i = bx * 512 + tid; i < DEPTH * 16 * NMOD; i += G * 512) {
            const int n = i % NMOD, l = i / (16 * NMOD);
            float s = b_ada[(size_t)l * NMOD + n];
#pragma unroll
            for (int kc = 0; kc < 8; ++kc) s += MODP[(size_t)kc * DEPTH * 16 * NMOD + i];
            MOD[i] = s;
        }
    }
    SEAM(1);

    for (int layer = 0; layer < DEPTH; ++layer) {
        const int pb = 2 + 11 * layer;
        if (PH_ON(2) && IN(pb + 0)) {
            PHASE_IDS();
            constexpr int I_IN = 64 * (LDP / 64), I_A = 32 * 32, I_O = 64 * 32, I_UP = 64 * (NUP / 64), I_DN = (DFF / 32) * 32;
            constexpr int I_DN_LATE = 4096;
            constexpr int NITEMS = I_IN + 2 * I_A + I_O + I_UP + I_DN - I_DN_LATE;
            const GAS float* modl = WSP(float, WS_MOD) + (size_t)layer * 16 * NMOD;
            const GAS float* g_mix = KIN(9) + (size_t)layer * DM;
            GAS float* X = (GAS float*)kargs()->out; GAS bf16_t* HB = WSP(bf16_t, WS_HB);
            norm_rows<false>((layer == 0) ? KIN(0) : (const GAS float*)X, g_mix, modl, HB, nullptr, gw, NGW, lane);
            for (int it = gw; it < NITEMS; it += NGW) {
                int r = it;
                if (r < I_IN) { convert_item<1>(KIN(3) + (size_t)layer * DM * IN_W, IN_W, WSP(bf16_t, WS_WIN), DM, 0, LDP / 64, r, lane); continue; } r -= I_IN;
                if (r < I_A) { convert_item<0>(KIN(4) + (size_t)layer * 1024 * DM, DM, WSP(bf16_t, WS_WAB), DM, 0, 32, r, lane); continue; } r -= I_A;
                if (r < I_A) { convert_item<0>(KIN(5) + (size_t)layer * 1024 * DM, DM, WSP(bf16_t, WS_WAB), DM, 1024, 32, r, lane); continue; } r -= I_A;
                if (r < I_O) { convert_item<0>(KIN(6) + (size_t)layer * DM * DM, DM, WSP(bf16_t, WS_WO), DM, 0, 32, r, lane); continue; } r -= I_O;
                if (r < I_UP) { convert_item<2>(KIN(11) + (size_t)layer * DM * NUP, NUP, WSP(bf16_t, WS_WUP), DM, 0, NUP / 64, r, lane); continue; } r -= I_UP;
                convert_item<0>(KIN(14) + (size_t)layer * DFF * DM, DM, WSP(bf16_t, WS_WDN), DFF, 0, 32, r + I_DN_LATE, lane);
            }
            __syncthreads();
        }
        SEAM(pb + 0);
        if (PH_ON(3) && IN(pb + 1)) {
            pg8::Gemm g{WSP(bf16_t, WS_HB), WSP(bf16_t, WS_WIN), MTOK, LDP, DM}; pg8::StaticOrder S; S.init(MTOK, LDP, G, bx);
            EpiInProj E{WSP(bf16_t, WS_PROJ), WSP(float, WS_COS128), WSP(float, WS_SIN128), WSP(float, WS_COS64), WSP(float, WS_SIN64), WSP(bf16_t, WS_ACT)};
            pg8::gemm_phase<EpiInProj, pg8::StaticOrder, true, true>(lds, g, S, E);
            if (bx >= G / 2) { PHASE_IDS(); for (int r = (bx - G / 2) * 8 + wave; r < 4096; r += (G - G / 2) * 8) convert_item<0>(KIN(14) + (size_t)layer * DFF * DM, DM, WSP(bf16_t, WS_WDN), DFF, 0, 32, r, lane); }
        }
        SEAM(pb + 1);
        if (PH_ON(4) && IN(pb + 2)) {
            const GAS bf16_t* PROJ = WSP(bf16_t, WS_PROJ);
            { PHASE_IDS(); GAS unsigned long long* MK = WSP(unsigned long long, WS_MASK);
              for (int idx = gw; idx < MTOK / 2; idx += NGW) { const int b = idx >> 10, tp = ((idx & 1023) + 131 * (idx / NGW)) & 1023;
                  idxsel_pair(PROJ, WSP(bf16_t, WS_ACT), MK, b, 2 * tp, lane, (LAS unsigned*)(lds + wave * 16384)); }
              __syncthreads(); }
            for (int P = bx; P < 512; P += G) {
                const int bh = P >> 2, y = P & 3;
                sb_attn_unit((LAS char*)lds, PROJ, WSP(bf16_t, WS_Y), bh >> 3, bh & 7, y);
                sb_attn_unit((LAS char*)lds, PROJ, WSP(bf16_t, WS_Y), bh >> 3, bh & 7, 7 - y);
            }
        }
        SEAM(pb + 2);
        if (PH_ON(6) && IN(pb + 4)) {
            const GAS bf16_t* PROJ = WSP(bf16_t, WS_PROJ); const GAS unsigned long long* MK = WSP(unsigned long long, WS_MASK);
            for (int P = bx; P < 512; P += G) {
                const int bh = P >> 2, y = P & 3;
                dsa_attn_unit((LAS char*)lds, PROJ, MK, WSP(bf16_t, WS_Y), bh >> 3, bh & 7, y);
                dsa_attn_unit((LAS char*)lds, PROJ, MK, WSP(bf16_t, WS_Y), bh >> 3, bh & 7, 7 - y);
            }
        }
        SEAM(pb + 4);
        if (PH_ON(7) && IN(pb + 5)) {
            pg8::Gemm g{WSP(bf16_t, WS_Y), WSP(bf16_t, WS_WAB), MTOK, DM, DM}; pg8::StaticOrder S; S.init(MTOK, DM, G, bx);
            EpiGate E{WSP(bf16_t, WS_PROJ), WSP(bf16_t, WS_HB)};
            pg8::gemm_phase<EpiGate, pg8::StaticOrder, true, true>(lds, g, S, E);
        }
        SEAM(pb + 5);
        if (PH_ON(8) && IN(pb + 6)) {
            pg8::Gemm g{WSP(bf16_t, WS_HB), WSP(bf16_t, WS_WO), MTOK, DM, DM}; pg8::StaticOrder S; S.init(MTOK, DM, G, bx);
            EpiResid E{(GAS float*)kargs()->out, (layer == 0) ? KIN(0) : (const GAS float*)kargs()->out, WSP(float, WS_MOD) + (size_t)layer * 16 * NMOD + 2 * DM};
            pg8::gemm_phase<EpiResid, pg8::StaticOrder, true, true>(lds, g, S, E);
        }
        SEAM(pb + 6);
        if (PH_ON(9) && IN(pb + 7)) {
            PHASE_IDS();
            const GAS float* modl = WSP(float, WS_MOD) + (size_t)layer * 16 * NMOD;
            const GAS float* g_ffn = KIN(10) + (size_t)layer * DM;
            const GAS float* X = (const GAS float*)kargs()->out; GAS bf16_t* HB = WSP(bf16_t, WS_HB);
            norm_rows<false>(X, g_ffn, modl + 3 * DM, HB, nullptr, gw, NGW, lane);
        }
        SEAM(pb + 7);
        if (PH_ON(10) && IN(pb + 8)) {
            pg8::Gemm g{WSP(bf16_t, WS_HB), WSP(bf16_t, WS_WUP), MTOK, NUP, DM}; pg8::StaticOrder S; S.init(MTOK, NUP, G, bx);
            EpiConv E{WSP(bf16_t, WS_ACT), WSP(float, WS_H0), WSP(float, WS_H1), KIN(12) + (size_t)layer * 3 * NUP, KIN(13) + (size_t)layer * NUP, lds + RING_BYTES + 1024};
            pg8::gemm_phase<EpiConv, pg8::StaticOrder, true, true>(lds, g, S, E);
        }
        SEAM(pb + 8);
        if (PH_ON(11) && IN(pb + 9)) {
            PHASE_IDS();
            const GAS float* cw = KIN(12) + (size_t)layer * 3 * NUP; const GAS float* cb = KIN(13) + (size_t)layer * NUP;
            const GAS float* H0 = WSP(float, WS_H0); const GAS float* H1 = WSP(float, WS_H1); GAS bf16_t* ACT = WSP(bf16_t, WS_ACT);
            for (int item = bx * 512 + tid; item < 128 * 704; item += G * 512) {
                const int pm = item / 704, cg = item % 704, ch = cg * 8, pn = ch >> 7, cc = ch & 127;
                const bool first = (pm & 7) == 0;
                float um2[2][8], um1[2][8], u0[2][8], u1[2][8];
#pragma unroll
                for (int ab = 0; ab < 2; ++ab) {
                    const int col = pn * 256 + ab * 128 + cc;
#pragma unroll
                    for (int h = 0; h < 2; ++h) {
                        const f32x4 a0 = *(const GAS f32x4*)(H0 + ((size_t)pm * 2 + 0) * NUP + col + 4 * h), a1 = *(const GAS f32x4*)(H0 + ((size_t)pm * 2 + 1) * NUP + col + 4 * h);
                        f32x4 p2 = {0.f, 0.f, 0.f, 0.f}, p1 = {0.f, 0.f, 0.f, 0.f};
                        if (!first) { p2 = *(const GAS f32x4*)(H1 + ((size_t)(pm - 1) * 2 + 0) * NUP + col + 4 * h); p1 = *(const GAS f32x4*)(H1 + ((size_t)(pm - 1) * 2 + 1) * NUP + col + 4 * h); }
#pragma unroll
                        for (int j = 0; j < 4; ++j) { um2[ab][4 * h + j] = p2[j]; um1[ab][4 * h + j] = p1[j]; u0[ab][4 * h + j] = a0[j]; u1[ab][4 * h + j] = a1[j]; }
                    }
                }
                float o0[8], o1[8];
#pragma unroll
                for (int j = 0; j < 8; ++j) {
                    const float wa0 = cw[ch + j], wa1 = cw[NUP + ch + j], wa2 = cw[2 * NUP + ch + j], ba = cb[ch + j];
                    const float wb0 = cw[DFF + ch + j], wb1 = cw[NUP + DFF + ch + j], wb2 = cw[2 * NUP + DFF + ch + j], bb = cb[DFF + ch + j];
                    const float av0 = ba + wa0 * um2[0][j] + wa1 * um1[0][j] + wa2 * u0[0][j], bv0 = bb + wb0 * um2[1][j] + wb1 * um1[1][j] + wb2 * u0[1][j];
                    const float av1 = ba + wa0 * um1[0][j] + wa1 * u0[0][j] + wa2 * u1[0][j], bv1 = bb + wb0 * um1[1][j] + wb1 * u0[1][j] + wb2 * u1[1][j];
                    o0[j] = av0 * fast_sigmoid(av0) * bv0; o1[j] = av1 * fast_sigmoid(av1) * bv1;
                }
                u32x4 q0 = {cvtpk(o0[0], o0[1]), cvtpk(o0[2], o0[3]), cvtpk(o0[4], o0[5]), cvtpk(o0[6], o0[7])}, q1 = {cvtpk(o1[0], o1[1]), cvtpk(o1[2], o1[3]), cvtpk(o1[4], o1[5]), cvtpk(o1[6], o1[7])};
                *(GAS u32x4*)(ACT + (size_t)(pm * 256) * DFF + ch) = q0; *(GAS u32x4*)(ACT + (size_t)(pm * 256 + 1) * DFF + ch) = q1;
            }
        }
        SEAM(pb + 9);
        if (PH_ON(12) && IN(pb + 10)) {
            pg8::Gemm g{WSP(bf16_t, WS_ACT), WSP(bf16_t, WS_WDN), MTOK, DM, DFF}; pg8::StaticOrder S; S.init(MTOK, DM, G, bx);
            EpiResid E{(GAS float*)kargs()->out, (const GAS float*)kargs()->out, WSP(float, WS_MOD) + (size_t)layer * 16 * NMOD + 5 * DM};
            pg8::gemm_phase<EpiResid, pg8::StaticOrder, true, true>(lds, g, S, E);
        }
        SEAM(pb + 10);
    }

    if (PH_ON(13) && IN(NPHASE - 1)) {
            PHASE_IDS();
        GAS float* X = (GAS float*)kargs()->out; const GAS float* g_final = KIN(15);
        f32x4 gm[8];
#pragma unroll
        for (int j = 0; j < 8; ++j) gm[j] = ((const GAS f32x4*)g_final + lane)[64 * j];
        for (int wv = gw; wv < NBATCH * 128; wv += NGW) {
            const int b = wv >> 7, rb = wv & 127;
            f32x4 cur[8], nxt[8];
#pragma unroll
            for (int j = 0; j < 8; ++j) cur[j] = ((const GAS f32x4*)(X + (size_t)(b * SEQ + rb) * DM) + lane)[64 * j];
            for (int k = 0; k < 16; ++k) {
                const int row = b * SEQ + rb + 128 * k;
                if (k + 1 < 16) {
#pragma unroll
                    for (int j = 0; j < 8; ++j) nxt[j] = ((const GAS f32x4*)(X + (size_t)(row + 128) * DM) + lane)[64 * j]; }
                float ss = 0.f;
#pragma unroll
                for (int j = 0; j < 8; ++j) ss += (cur[j][0] * cur[j][0] + cur[j][1] * cur[j][1]) + (cur[j][2] * cur[j][2] + cur[j][3] * cur[j][3]);
                const float rs = 1.f / sqrtf(wave_sum(ss) * (1.f / DM) + NORM_EPS);
#pragma unroll
                for (int j = 0; j < 8; ++j) ((GAS f32x4*)(X + (size_t)row * DM) + lane)[64 * j] = cur[j] * rs * gm[j];
#pragma unroll
                for (int j = 0; j < 8; ++j) cur[j] = nxt[j];
            }
        }
    }
#undef IN
#undef SEAM
}

extern "C" void kernel_launch(void* const* d_in, const int* in_sizes, int n_in, void* d_out, int out_size, void* d_ws, size_t ws_size, hipStream_t stream) {
    static int grid = 0;
    if (grid == 0) {
        if (n_in != 16 || out_size != MTOK * DM || ws_size < WS_END) { fprintf(stderr, "kernel_launch: unexpected shapes (n_in %d out %d ws %zu)\n", n_in, out_size, ws_size); grid = -1; return; }
        int dev = 0, cus = 0, per_cu = 0;
        if (hipGetDevice(&dev) != hipSuccess || hipDeviceGetAttribute(&cus, hipDeviceAttributeMultiprocessorCount, dev) != hipSuccess) { grid = -1; return; }
        if (hipFuncSetAttribute((const void*)fwd, hipFuncAttributeMaxDynamicSharedMemorySize, LDS_BYTES) != hipSuccess) { fprintf(stderr, "kernel_launch: hipFuncSetAttribute failed\n"); grid = -1; return; }
        if (hipOccupancyMaxActiveBlocksPerMultiprocessor(&per_cu, (const void*)fwd, 512, LDS_BYTES) != hipSuccess || per_cu < 1) { fprintf(stderr, "kernel_launch: occupancy query says %d\n", per_cu); }
        (void)hipGetLastError();
        grid = cus;
    }
    if (grid < 0) return;
    (void)hipMemsetAsync((char*)d_ws + WS_CTL, 0, CTL_BYTES, stream);
    Args a{};
    for (int i = 0; i < 16; ++i) a.in[i] = (const float*)d_in[i];
    a.out = (float*)d_out; a.ws = (unsigned char*)d_ws;
#if MK_ONE_LAUNCH
    a.ph_lo = 0; a.ph_hi = NPHASE; a.li = 0;
    hipLaunchKernelGGL(fwd, dim3(grid), dim3(512), LDS_BYTES, stream, a);
#else
    for (int p = 0; p < NPHASE; ++p) { a.ph_lo = p; a.ph_hi = p + 1; a.li = p; hipLaunchKernelGGL(fwd, dim3(grid), dim3(512), LDS_BYTES, stream, a); }
#endif
}
```
